# Optimizing an MI355X kernel written in HIP

```python
import jax, jax.numpy as jnp
from jax import lax
import numpy as np

D_MODEL = 1024
BATCH = 8
SEQ = 2048
DEPTH = 1

GRID_W = 64
CTX_LEN = 256
HEAD_DIM = 64
ATTN_Q_HEADS = 8
ATTN_KV_HEADS = 2
ATTN_GROUP = ATTN_Q_HEADS // ATTN_KV_HEADS
WINDOW = 128
ATTN_BLOCK = 128
ROPE_BASE = 10000.0
DN_HEADS = 8
DN_HEAD_DIM = 64
CONV_W = 3
CHUNK = 64
N_DIR = 2
D_FF = 4 * D_MODEL
EPS = 1e-6
NEG_INF = -1e30

ATTN_WIDTH = ATTN_Q_HEADS * HEAD_DIM
KV_WIDTH = ATTN_KV_HEADS * HEAD_DIM
DN_WIDTH = DN_HEADS * DN_HEAD_DIM
IN_SPLITS = (ATTN_WIDTH, KV_WIDTH, KV_WIDTH, DN_WIDTH, DN_WIDTH, DN_WIDTH, DN_WIDTH,
             N_DIR * DN_HEADS, N_DIR * DN_HEADS, D_MODEL, D_MODEL)
IN_WIDTH = 4 * DN_WIDTH + ATTN_WIDTH + 2 * KV_WIDTH + 2 * N_DIR * DN_HEADS + 2 * D_MODEL

kernel_name = "hybrid_swa_gdn_dit_layer"


def rms_norm(x, g):
    xf = x.astype(jnp.float32)
    return xf * lax.rsqrt(jnp.mean(xf * xf, axis=-1, keepdims=True) + EPS) * g.astype(jnp.float32)


def l2_normalize(x):
    return x * lax.rsqrt(jnp.sum(x * x, axis=-1, keepdims=True) + EPS)


def split_cols(p):
    offsets = [int(o) for o in np.cumsum(IN_SPLITS)[:-1]]
    return jnp.split(p, offsets, axis=-1)


def axial_rope(x, row, col):
    half = HEAD_DIM // 2
    n_freq = half // 2
    freqs = ROPE_BASE ** (-jnp.arange(n_freq, dtype=jnp.float32) / n_freq)

    def rot(xh, pos):
        ang = pos.astype(jnp.float32)[:, None] * freqs
        cos = jnp.cos(ang)[None, :, None, :]
        sin = jnp.sin(ang)[None, :, None, :]
        x1, x2 = xh[..., :n_freq], xh[..., n_freq:]
        return jnp.concatenate([x1 * cos - x2 * sin, x1 * sin + x2 * cos], axis=-1)

    return jnp.concatenate([rot(x[..., :half], row), rot(x[..., half:], col)], axis=-1)


def centred_short_conv(x, w):
    pad = CONV_W // 2
    T = x.shape[1]
    xp = jnp.pad(x, ((0, 0), (pad, CONV_W - 1 - pad), (0, 0)))
    y = sum(xp[:, tap:tap + T] * w[tap] for tap in range(CONV_W))
    return jax.nn.silu(y)


def gated_delta_chunked(q, k, v, g_log, beta, s0):
    B, T, H, dk = q.shape
    n = T // CHUNK

    def chunks(a):
        return jnp.moveaxis(a.reshape((B, n, CHUNK, H) + a.shape[3:]), 3, 1)

    qc, kc, vc = chunks(q), chunks(k), chunks(v)
    gc, bc = chunks(g_log), chunks(beta)
    G = jnp.cumsum(gc, axis=-1)
    idx = jnp.arange(CHUNK)
    strict = idx[:, None] > idx[None, :]
    incl = idx[:, None] >= idx[None, :]
    diff = G[..., :, None] - G[..., None, :]
    dec_strict = jnp.where(strict, jnp.exp(jnp.where(strict, diff, 0.0)), 0.0)
    dec_incl = jnp.where(incl, jnp.exp(jnp.where(incl, diff, 0.0)), 0.0)
    kk = jnp.einsum('bhnid,bhnjd->bhnij', kc, kc)
    t_mat = jnp.eye(CHUNK, dtype=jnp.float32) + bc[..., :, None] * dec_strict * kk
    eG = jnp.exp(G)
    w_mat = lax.linalg.triangular_solve(t_mat, (bc * eG)[..., None] * kc, left_side=True, lower=True,
                                        unit_diagonal=True)
    u_v = lax.linalg.triangular_solve(t_mat, bc[..., None] * vc, left_side=True, lower=True,
                                      unit_diagonal=True)
    intra = dec_incl * jnp.einsum('bhnid,bhnjd->bhnij', qc, kc)
    q_dec = eG[..., None] * qc
    g_last = G[..., -1]
    k_tail = jnp.exp(g_last[..., None] - G)[..., None] * kc

    def step(S, xs):
        w_c, uv_c, qd_c, intra_c, kt_c, gl_c = xs
        u = uv_c - jnp.einsum('bhck,bhkv->bhcv', w_c, S)
        o = jnp.einsum('bhck,bhkv->bhcv', qd_c, S) + jnp.einsum('bhij,bhjv->bhiv', intra_c, u)
        S = jnp.exp(gl_c)[..., None, None] * S + jnp.einsum('bhck,bhcv->bhkv', kt_c, u)
        return S, o

    xs = tuple(jnp.moveaxis(a, 2, 0) for a in (w_mat, u_v, q_dec, intra, k_tail, g_last))
    s_final, o = lax.scan(step, s0, xs)
    o = jnp.transpose(o, (1, 0, 3, 2, 4)).reshape(B, T, H, v.shape[-1])
    return o, s_final


def bidir_delta(q, k, v, g, beta, s0_f, s0_b):
    o_f, s_f = gated_delta_chunked(q, k, v, g[:, :, 0], beta[:, :, 0], s0_f)
    flip = lambda a: jnp.flip(a, axis=1)
    o_b, s_b = gated_delta_chunked(flip(q), flip(k), flip(v), flip(g[:, :, 1]), flip(beta[:, :, 1]), s0_b)
    return o_f + flip(o_b), s_f, s_b


def window_ctx_attention(q, k, v, k_ctx, v_ctx, sink):
    B, S = q.shape[:2]
    L = k_ctx.shape[1]
    nb = S // ATTN_BLOCK
    qb = q.reshape(B, nb, ATTN_BLOCK, ATTN_KV_HEADS, ATTN_GROUP, HEAD_DIM)

    def band(a):
        ap = jnp.pad(a, ((0, 0), (ATTN_BLOCK, ATTN_BLOCK), (0, 0), (0, 0)))
        ap = ap.reshape(B, nb + 2, ATTN_BLOCK, ATTN_KV_HEADS, HEAD_DIM)
        return jnp.concatenate([ap[:, :-2], ap[:, 1:-1], ap[:, 2:]], axis=2)

    kb, vb = band(k), band(v)
    blk = jnp.arange(nb)[:, None, None]
    qpos = blk * ATTN_BLOCK + jnp.arange(ATTN_BLOCK)[None, :, None]
    kpos = (blk - 1) * ATTN_BLOCK + jnp.arange(3 * ATTN_BLOCK)[None, None, :]
    valid = (jnp.abs(qpos - kpos) <= WINDOW) & (kpos >= 0) & (kpos < S)
    scale = HEAD_DIM ** -0.5
    s_loc = jnp.einsum('bnqgrd,bnkgd->bngrqk', qb, kb) * scale
    s_loc = jnp.where(valid[None, :, None, None], s_loc, NEG_INF)
    s_ctx = jnp.einsum('bnqgrd,bkgd->bngrqk', qb, k_ctx) * scale
    s_sink = jnp.broadcast_to(sink.reshape(ATTN_KV_HEADS, ATTN_GROUP)[None, None, :, :, None, None],
                              s_loc.shape[:-1] + (1,))
    p = jax.nn.softmax(jnp.concatenate([s_loc, s_ctx, s_sink], axis=-1).astype(jnp.float32), axis=-1)
    n_loc = 3 * ATTN_BLOCK
    o = (jnp.einsum('bngrqk,bnkgd->bnqgrd', p[..., :n_loc], vb)
         + jnp.einsum('bngrqk,bkgd->bnqgrd', p[..., n_loc:n_loc + L], v_ctx))
    return o.reshape(B, S, ATTN_WIDTH)


def ctx_self_attention(q, k, v, sink):
    B, L = q.shape[:2]
    qg = q.reshape(B, L, ATTN_KV_HEADS, ATTN_GROUP, HEAD_DIM)
    s = jnp.einsum('bqgrd,bkgd->bgrqk', qg, k) * HEAD_DIM ** -0.5
    s_sink = jnp.broadcast_to(sink.reshape(ATTN_KV_HEADS, ATTN_GROUP)[None, :, :, None, None], s.shape[:-1] + (1,))
    p = jax.nn.softmax(jnp.concatenate([s, s_sink], axis=-1).astype(jnp.float32), axis=-1)
    o = jnp.einsum('bgrqk,bkgd->bqgrd', p[..., :L], v)
    return o.reshape(B, L, ATTN_WIDTH)


def trunk_layer(x, ctx, c, c_ctx, w_ada, b_ada, g_norm1, w_in, q_norm_g, k_norm_g, attn_sink, conv_w,
                a_log, dt_bias, dn_norm_g, w_br_attn, w_br_dn, w_out, g_norm2, w_mlp1, w_mlp2, update_ctx):
    B, S = x.shape[:2]
    L = ctx.shape[1]
    rows = S // GRID_W
    row = jnp.broadcast_to(jnp.arange(rows)[:, None], (rows, GRID_W)).reshape(-1)
    col = jnp.broadcast_to(jnp.arange(GRID_W)[None, :], (rows, GRID_W)).reshape(-1)

    mod = jax.nn.silu(c.astype(jnp.float32)) @ w_ada + b_ada
    mod_c = jax.nn.silu(c_ctx.astype(jnp.float32)) @ w_ada + b_ada
    sh1, sc1, gt1, sh2, sc2, gt2 = [m[:, None] for m in jnp.split(mod, 6, axis=-1)]
    csh1, csc1, cgt1, csh2, csc2, cgt2 = jnp.split(mod_c, 6, axis=-1)

    h = rms_norm(x, g_norm1) * (1.0 + sc1) + sh1
    hc = rms_norm(ctx, g_norm1) * (1.0 + csc1) + csh1
    aq, ak, av, dq, dk, dv, dz, da, db, ga, gd = split_cols(h @ w_in)
    caq, cak, cav, cdq, cdk, cdv, cdz, cda, cdb, cga, cgd = split_cols(hc @ w_in)

    def heads(a, n_heads):
        return a.reshape(a.shape[0], a.shape[1], n_heads, HEAD_DIM)

    q_a = axial_rope(rms_norm(heads(aq, ATTN_Q_HEADS), q_norm_g), row, col)
    k_a = axial_rope(rms_norm(heads(ak, ATTN_KV_HEADS), k_norm_g), row, col)
    v_a = heads(av, ATTN_KV_HEADS)
    k_ac = rms_norm(heads(cak, ATTN_KV_HEADS), k_norm_g)
    v_ac = heads(cav, ATTN_KV_HEADS)
    y_attn = window_ctx_attention(q_a, k_a, v_a, k_ac, v_ac, attn_sink)

    def dn_inputs(pq, pk, pv, pa, pb):
        qkv = centred_short_conv(jnp.concatenate([pq, pk, pv], axis=-1), conv_w)
        q_d, k_d, v_d = jnp.split(qkv, 3, axis=-1)
        q_d = l2_normalize(heads(q_d, DN_HEADS)) * DN_HEAD_DIM ** -0.5
        k_d = l2_normalize(heads(k_d, DN_HEADS))
        v_d = heads(v_d, DN_HEADS)
        T = pq.shape[1]
        beta = jax.nn.sigmoid(pb.reshape(pb.shape[0], T, N_DIR, DN_HEADS))
        g = -jnp.exp(a_log) * jax.nn.softplus(pa.reshape(pa.shape[0], T, N_DIR, DN_HEADS) + dt_bias)
        return q_d, k_d, v_d, g, beta

    s_zero = jnp.zeros((B, DN_HEADS, DN_HEAD_DIM, DN_HEAD_DIM), jnp.float32)
    o_dc, s_cf, s_cb = bidir_delta(*dn_inputs(cdq, cdk, cdv, cda, cdb), s_zero, s_zero)
    o_dl, _, _ = bidir_delta(*dn_inputs(dq, dk, dv, da, db), s_cf, s_cb)

    def merge(y_a, o_d, z, gate_a, gate_d):
        y_d = (rms_norm(o_d, dn_norm_g) * jax.nn.silu(heads(z, DN_HEADS))).reshape(z.shape)
        y = jax.nn.sigmoid(gate_a) * (y_a @ w_br_attn) + jax.nn.sigmoid(gate_d) * (y_d @ w_br_dn)
        return y @ w_out

    def mlp(s, shift, scale_m):
        hm = rms_norm(s, g_norm2) * (1.0 + scale_m) + shift
        return jnp.square(jax.nn.relu(hm @ w_mlp1)) @ w_mlp2

    x_new = x.astype(jnp.float32) + gt1 * merge(y_attn, o_dl, dz, ga, gd)
    x_new = x_new + gt2 * mlp(x_new, sh2, sc2)

    if update_ctx:
        q_ac = rms_norm(heads(caq, ATTN_Q_HEADS), q_norm_g)
        y_attn_c = ctx_self_attention(q_ac, k_ac, v_ac, attn_sink)
        ctx = ctx.astype(jnp.float32) + cgt1 * merge(y_attn_c, o_dc, cdz, cga, cgd)
        ctx = ctx + cgt2 * mlp(ctx, csh2, csc2)
    return x_new, ctx


def setup_inputs(seed: int = 0) -> dict:
    key = jax.random.key(seed)
    ks = jax.random.split(key, 24)
    f32 = jnp.float32
    nrm = lambda k, shape, s: jax.random.normal(k, shape, f32) * s
    dt = jnp.exp(jax.random.uniform(ks[12], (DEPTH, N_DIR, DN_HEADS), f32, np.log(1e-3), np.log(1e-1)))
    return {
        "x": nrm(ks[0], (BATCH, SEQ, D_MODEL), 1.0),
        "c": nrm(ks[1], (BATCH, D_MODEL), 1.0),
        "ctx": nrm(ks[2], (BATCH, CTX_LEN, D_MODEL), 1.0),
        "c_ctx": nrm(ks[3], (D_MODEL,), 1.0),
        "w_ada": nrm(ks[4], (DEPTH, D_MODEL, 6 * D_MODEL), 0.5 * D_MODEL ** -0.5),
        "b_ada": nrm(ks[5], (DEPTH, 6 * D_MODEL), 0.02),
        "g_norm1": 1.0 + nrm(ks[6], (DEPTH, D_MODEL), 0.1),
        "w_in": nrm(ks[7], (DEPTH, D_MODEL, IN_WIDTH), D_MODEL ** -0.5),
        "q_norm_g": 1.0 + nrm(ks[8], (DEPTH, HEAD_DIM), 0.1),
        "k_norm_g": 1.0 + nrm(ks[9], (DEPTH, HEAD_DIM), 0.1),
        "attn_sink": nrm(ks[10], (DEPTH, ATTN_Q_HEADS), 0.5),
        "conv_w": nrm(ks[11], (DEPTH, CONV_W, 3 * DN_WIDTH), CONV_W ** -0.5),
        "a_log": jnp.log(jax.random.uniform(ks[13], (DEPTH, N_DIR, DN_HEADS), f32, 1.0, 16.0)),
        "dt_bias": dt + jnp.log(-jnp.expm1(-dt)),
        "dn_norm_g": 1.0 + nrm(ks[14], (DEPTH, DN_HEAD_DIM), 0.1),
        "w_br_attn": nrm(ks[15], (DEPTH, ATTN_WIDTH, D_MODEL), ATTN_WIDTH ** -0.5),
        "w_br_dn": nrm(ks[16], (DEPTH, DN_WIDTH, D_MODEL), DN_WIDTH ** -0.5),
        "w_out": nrm(ks[17], (DEPTH, D_MODEL, D_MODEL), D_MODEL ** -0.5),
        "g_norm2": 1.0 + nrm(ks[18], (DEPTH, D_MODEL), 0.1),
        "w_mlp1": nrm(ks[19], (DEPTH, D_MODEL, D_FF), D_MODEL ** -0.5),
        "w_mlp2": nrm(ks[20], (DEPTH, D_FF, D_MODEL), D_FF ** -0.5),
    }


def reference(x, c, ctx, c_ctx, w_ada, b_ada, g_norm1, w_in, q_norm_g, k_norm_g, attn_sink, conv_w,
              a_log, dt_bias, dn_norm_g, w_br_attn, w_br_dn, w_out, g_norm2, w_mlp1, w_mlp2):
    out_dtype = x.dtype
    for layer in range(DEPTH):
        x, ctx = trunk_layer(x, ctx, c, c_ctx, w_ada[layer], b_ada[layer], g_norm1[layer], w_in[layer],
                             q_norm_g[layer], k_norm_g[layer], attn_sink[layer], conv_w[layer],
                             a_log[layer], dt_bias[layer], dn_norm_g[layer], w_br_attn[layer],
                             w_br_dn[layer], w_out[layer], g_norm2[layer], w_mlp1[layer], w_mlp2[layer],
                             update_ctx=layer < DEPTH - 1)
    return x.astype(out_dtype)
```

```cpp
#include <hip/hip_runtime.h>
#include <hip/hip_cooperative_groups.h>
#include <cstdio>
#include <cstdint>
namespace cg = cooperative_groups;

namespace pg8 {
#define PG8_LAS __attribute__((address_space(3)))
typedef unsigned short bf16_t;
typedef short bf16x8 __attribute__((ext_vector_type(8)));
typedef float f32x4 __attribute__((ext_vector_type(4)));
typedef unsigned u32x4 __attribute__((ext_vector_type(4)));
constexpr int BM = 256, BK = 64, HALF = 128, HTB = HALF * BK * 2  , STAGE_BYTES = 8 * HTB, NXCD = 8, WGM = 8;

__host__ __device__ __forceinline__ int lds_byte(int r, int c) { const int st = (r >> 4) * 2 + (c >> 5), rr = r & 15, cc = c & 31, ob = rr * 64 + cc * 2; return st * 1024 + (ob ^ (((ob >> 9) & 1) << 5)); }
__host__ __device__ __forceinline__ void stage_rc(int b, int& R, int& C) { const int st = b / 1024, sb = b % 1024, swz = sb ^ (((sb >> 9) & 1) << 5); R = (st >> 1) * 16 + swz / 64; C = (st & 1) * 32 + (swz % 64) / 2; }
__host__ __device__ __forceinline__ int perm32(int rho) { const int n = rho >> 4, i = rho & 15; return 8 * (i >> 2) + 4 * n + (i & 3); }

struct Unit { int pm, pn; };
struct Gemm { const bf16_t* A; const bf16_t* Bt; int M, N, K; int nt = 0, jt = 0; size_t ja = 0, jb = 0; };


typedef unsigned u32x2 __attribute__((ext_vector_type(2)));
typedef short s16x4 __attribute__((ext_vector_type(4)));
__device__ __forceinline__ unsigned pk2(float a, float b) { typedef __bf16 bv2 __attribute__((ext_vector_type(2))); bv2 v; v[0] = (__bf16)a; v[1] = (__bf16)b; return __builtin_bit_cast(unsigned, v); }
__device__ __forceinline__ float lo16(unsigned u) { return __uint_as_float(u << 16); }
__device__ __forceinline__ float hi16(unsigned u) { return __uint_as_float(u & 0xffff0000u); }
__device__ __forceinline__ float bf2f(bf16_t v) { return __uint_as_float(((unsigned)v) << 16); }

__device__ __forceinline__ void map_static(int L, int nwg, int nN, int& pm, int& pn) {
    const int q = nwg / NXCD, xcd = L % NXCD, off = L / NXCD, wgid = xcd * q + off;
    const int nig = WGM * nN, gid = wgid / nig; pm = gid * WGM + ((wgid % nig) % WGM); pn = (wgid % nig) / WGM;
}
struct SchedStd {
    int nN, nwg, G, c;
    __device__ __forceinline__ bool next(int i, Unit& u) const { const long L = (long)i * G + c; if (L >= nwg) return false; map_static((int)L, nwg, nN, u.pm, u.pn); return true; }
    __device__ __forceinline__ void a_ready(const Unit&) const {}
    __device__ __forceinline__ void done(const Unit&) const {}
};
struct SchedIn {
    int G, c;
    __device__ __forceinline__ bool next(int i, Unit& u) const {
        const long L = (long)i * G + c; if (L >= 1256) return false;
        if (L < 1216) map_static((int)L, 1216, 19, u.pm, u.pn);
        else { const int Lc = (int)L - 1216, t = Lc >> 3; u.pm = 64 + (Lc & 7); u.pn = t == 0 ? 2 : t + 4; }
        return true;
    }
    __device__ __forceinline__ void a_ready(const Unit&) const {}
    __device__ __forceinline__ void done(const Unit&) const {}
};
struct SchedBr {
    int G, c;
    __device__ __forceinline__ bool next(int i, Unit& u) const {
        const long L = (long)(i >> 1) * G + c; if (L >= 256) return false; const int br = i & 1; int pm, pn; map_static((int)L, 256, 4, pm, pn);
        u.pm = pm + 64 * br; u.pn = pn + 4 * br; return true;
    }
    __device__ __forceinline__ void a_ready(const Unit&) const {}
    __device__ __forceinline__ void done(const Unit&) const {}
};

struct EpiP { bf16_t* AQ; bf16_t* AKV; bf16_t* DQKV; bf16_t* DZ; bf16_t* GATES; bf16_t* Y; float* AB; const float* x; const float* mod; float* out; bf16_t* ACT; const float* g2; bf16_t* H2; float* rowsq; const float* bias; };
template <int MODE> struct Epi {
    static constexpr bool PERM = true, AFTER_DRAIN = false, HAS_MID = (MODE == 1);
    EpiP p;
    __device__ __forceinline__ void operator()(const f32x4 (&acc)[2][2][4][2], const Unit& u, int wr, int wc, int fr, int fq) const {
        if (MODE == 0) {
            const int pn = u.pn; const int row0 = u.pm * BM + wr * 64 + fr;
            if (pn >= 11) {
                const int colg = (pn - 11) * 128 + wc * 32 + 8 * fq;
#pragma unroll
                for (int ai = 0; ai < 2; ++ai)
#pragma unroll
                    for (int m = 0; m < 4; ++m) { bf16_t* rp = p.GATES + (size_t)(row0 + ai * HALF + m * 16) * 2048 + colg; f32x4 rr[2], sd[2];
#pragma unroll
                        for (int n = 0; n < 2; ++n)
#pragma unroll
                            for (int j = 0; j < 4; ++j) { const float ga = fminf(fmaxf(acc[ai][0][m][n][j], -30.f), 30.f), gd = fminf(fmaxf(acc[ai][1][m][n][j], -30.f), 30.f);
                                const float ea = 1.0f + __expf(-ga), ed = 1.0f + __expf(-gd), ia = __builtin_amdgcn_rcpf(ea); rr[n][j] = ed * ia; sd[n][j] = __builtin_amdgcn_rcpf(ed); }
                        u32x4 w; w.x = pk2(rr[0][0], rr[0][1]); w.y = pk2(rr[0][2], rr[0][3]); w.z = pk2(rr[1][0], rr[1][1]); w.w = pk2(rr[1][2], rr[1][3]); *(u32x4*)rp = w;
                        w.x = pk2(sd[0][0], sd[0][1]); w.y = pk2(sd[0][2], sd[0][3]); w.z = pk2(sd[1][0], sd[1][1]); w.w = pk2(sd[1][2], sd[1][3]); *(u32x4*)(rp + 1024) = w; }
                return;
            }
            bf16_t* base; int ld, cofs;
            if (pn < 2) { base = p.AQ; ld = 512; cofs = 0; } else if (pn == 2) { base = p.AKV; ld = 256; cofs = 512; } else if (pn < 9) { base = p.DQKV; ld = 1536; cofs = 768; }
            else { base = p.DZ; ld = 512; cofs = 2304; }
            const int colt = pn * BM - cofs + wc * 32 + 8 * fq;
#pragma unroll
            for (int ai = 0; ai < 2; ++ai)
#pragma unroll
                for (int m = 0; m < 4; ++m) { bf16_t* rp = base + (size_t)(row0 + ai * HALF + m * 16) * ld + colt;
#pragma unroll
                    for (int bj = 0; bj < 2; ++bj) { const f32x4 v0 = acc[ai][bj][m][0], v1 = acc[ai][bj][m][1];
                        u32x4 w; w.x = pk2(v0[0], v0[1]); w.y = pk2(v0[2], v0[3]); w.z = pk2(v1[0], v1[1]); w.w = pk2(v1[2], v1[3]); *(u32x4*)(rp + bj * HALF) = w; } }
        } else if (MODE == 1) {
            const int row0 = u.pm * BM + wr * 64 + fr, col0 = u.pn * BM + wc * 32 + 8 * fq;
#pragma unroll
            for (int ai = 0; ai < 2; ++ai)
#pragma unroll
                for (int m = 0; m < 4; ++m) { const size_t r = (size_t)(row0 + ai * HALF + m * 16); const bf16_t* gp = p.GATES + r * 2048 + 1024 + col0; bf16_t* yp = p.Y + r * 1024 + col0;
#pragma unroll
                    for (int bj = 0; bj < 2; ++bj) { const f32x4 a0 = acc[ai][bj][m][0], a1 = acc[ai][bj][m][1]; const u32x4 g = *(const u32x4*)(gp + bj * HALF);
                        u32x4 w; w.x = pk2(lo16(g.x) * a0[0], hi16(g.x) * a0[1]); w.y = pk2(lo16(g.y) * a0[2], hi16(g.y) * a0[3]); w.z = pk2(lo16(g.z) * a1[0], hi16(g.z) * a1[1]); w.w = pk2(lo16(g.w) * a1[2], hi16(g.w) * a1[3]);
                        *(u32x4*)(yp + bj * HALF) = w; } }
        } else if (MODE == 2) {
            const int row0 = u.pm * BM + wr * 64 + fr, col0 = u.pn * BM + wc * 32 + 8 * fq; const float* mb = p.mod + (size_t)(u.pm >> 3) * 6144 + col0;
            f32x4 gv[2][2], hv[2][2];
#pragma unroll
            for (int bj = 0; bj < 2; ++bj)
#pragma unroll
                for (int n = 0; n < 2; ++n) { gv[bj][n] = *(const f32x4*)(mb + 2048 + bj * HALF + n * 4); hv[bj][n] = *(const f32x4*)(p.g2 + col0 + bj * HALF + n * 4) * (*(const f32x4*)(mb + 4096 + bj * HALF + n * 4) + 1.0f); }
#pragma unroll
            for (int ai = 0; ai < 2; ++ai)
#pragma unroll
                for (int m = 0; m < 4; ++m) { const int row = row0 + ai * HALF + m * 16; const size_t off = (size_t)row * 1024 + col0; float ss = 0.f;
#pragma unroll
                    for (int bj = 0; bj < 2; ++bj) { f32x4 a2[2];
#pragma unroll
                        for (int n = 0; n < 2; ++n) { const f32x4 b = *(const f32x4*)(p.x + off + bj * HALF + n * 4); const f32x4 x1 = b + gv[bj][n] * acc[ai][bj][m][n];
                            *(f32x4*)(p.out + off + bj * HALF + n * 4) = x1; ss += x1[0] * x1[0] + x1[1] * x1[1] + x1[2] * x1[2] + x1[3] * x1[3]; a2[n] = x1 * hv[bj][n]; }
                        u32x4 w; w.x = pk2(a2[0][0], a2[0][1]); w.y = pk2(a2[0][2], a2[0][3]); w.z = pk2(a2[1][0], a2[1][1]); w.w = pk2(a2[1][2], a2[1][3]); *(u32x4*)(p.H2 + off + bj * HALF) = w; }
                    ss += __shfl_xor(ss, 16); ss += __shfl_xor(ss, 32); if (fq == 0) atomicAdd(p.rowsq + row, ss); }
        } else if (MODE == 4) {
            const int row0 = u.pm * BM + wr * 64 + fr, col0 = u.pn * BM + wc * 32 + 8 * fq; const float* gt = p.mod + (size_t)(u.pm >> 3) * 6144 + 5120 + col0;
            f32x4 gv[2][2];
#pragma unroll
            for (int bj = 0; bj < 2; ++bj)
#pragma unroll
                for (int n = 0; n < 2; ++n) gv[bj][n] = *(const f32x4*)(gt + bj * HALF + n * 4);
#pragma unroll
            for (int ai = 0; ai < 2; ++ai)
#pragma unroll
                for (int m = 0; m < 4; ++m) { const size_t off = (size_t)(row0 + ai * HALF + m * 16) * 1024 + col0;
#pragma unroll
                    for (int bj = 0; bj < 2; ++bj)
#pragma unroll
                        for (int n = 0; n < 2; ++n) { const f32x4 b = *(const f32x4*)(p.out + off + bj * HALF + n * 4);
                            *(f32x4*)(p.out + off + bj * HALF + n * 4) = b + gv[bj][n] * acc[ai][bj][m][n]; } }
        } else {
            const int row0 = u.pm * BM + wr * 64 + fr, col0 = u.pn * BM + wc * 32 + 8 * fq; const float* bp = p.bias + (size_t)(u.pm >> 3) * 4096 + col0;
            f32x4 bv[2][2];
#pragma unroll
            for (int bj = 0; bj < 2; ++bj)
#pragma unroll
                for (int n = 0; n < 2; ++n) bv[bj][n] = *(const f32x4*)(bp + bj * HALF + n * 4);
#pragma unroll
            for (int ai = 0; ai < 2; ++ai)
#pragma unroll
                for (int m = 0; m < 4; ++m) { const int row = row0 + ai * HALF + m * 16; bf16_t* rp = p.ACT + (size_t)row * 4096 + col0; const float rstd = rsqrtf(p.rowsq[row] * (1.0f / 1024.0f) + 1e-6f);
#pragma unroll
                    for (int bj = 0; bj < 2; ++bj) { f32x4 v0 = acc[ai][bj][m][0] * rstd + bv[bj][0], v1 = acc[ai][bj][m][1] * rstd + bv[bj][1];
#pragma unroll
                        for (int j = 0; j < 4; ++j) { const float t0 = fmaxf(v0[j], 0.f), t1 = fmaxf(v1[j], 0.f); v0[j] = t0 * t0; v1[j] = t1 * t1; }
                        u32x4 w; w.x = pk2(v0[0], v0[1]); w.y = pk2(v0[2], v0[3]); w.z = pk2(v1[0], v1[1]); w.w = pk2(v1[2], v1[3]); *(u32x4*)(rp + bj * HALF) = w; } }
        }
    }
    __device__ __forceinline__ void mid(f32x4 (&acc)[2][2][4][2], const Unit& u, int wr, int wc, int fr, int fq) const {
        const int row0 = u.pm * BM + wr * 64 + fr, col0 = u.pn * BM + wc * 32 + 8 * fq;
        const bf16_t* gp = p.GATES + (size_t)row0 * 2048 + col0;
#pragma unroll
        for (int ai = 0; ai < 2; ++ai)
#pragma unroll
            for (int m = 0; m < 4; ++m) { asm volatile("" : "+v"(gp));
#pragma unroll
                for (int bj = 0; bj < 2; ++bj) { const u32x4 g = *(const u32x4*)(gp + bj * HALF);
                    acc[ai][bj][m][0][0] *= lo16(g.x); acc[ai][bj][m][0][1] *= hi16(g.x); acc[ai][bj][m][0][2] *= lo16(g.y); acc[ai][bj][m][0][3] *= hi16(g.y);
                    acc[ai][bj][m][1][0] *= lo16(g.z); acc[ai][bj][m][1][1] *= hi16(g.z); acc[ai][bj][m][1][2] *= lo16(g.w); acc[ai][bj][m][1][3] *= hi16(g.w); }
                gp += (m == 3 ? (HALF - 48) : 16) * 2048;
                if (m == 1 || m == 3) asm volatile("" ::: "memory"); }
    }
};

template <class Epi, class Sched, bool ALIGN_EPI = false, bool SP2 = false>
__device__ __forceinline__ void gemm_phase(PG8_LAS unsigned char* lds, const Gemm g, const Sched& S, const Epi& E) {
    int tid_ = threadIdx.x; asm volatile("" : "+v"(tid_)); const int tid = tid_, wid = __builtin_amdgcn_readfirstlane(tid >> 6), lane = tid & 63, wr = wid >> 2, wc = wid & 3, fr = lane & 15, fq = lane >> 4;
    const int K = g.K, nt = g.nt ? g.nt : K / BK;
    unsigned voffA[2], voffB[2];
#pragma unroll
    for (int i = 0; i < 2; ++i) { int R, C; stage_rc(tid * 16 + i * 8192, R, C); const int Rb = Epi::PERM ? ((R & ~31) + perm32(R & 31)) : R;
        voffA[i] = (unsigned)(R * K + C) * 2u; voffB[i] = (unsigned)(Rb * K + C) * 2u; }
    const size_t kstep = (size_t)(BK * 2);
    const size_t hstep = (size_t)HALF * K * 2;
    const size_t tstep = 2 * hstep;
    const unsigned ldsw = (unsigned)wid * 1024u;
    const int aoff = lds_byte(wr * 64 + fr, fq * 8), boff = lds_byte(wc * 32 + fr, fq * 8);
#define PG8_SA(b, h) (((b) * 2 + (h)) * HTB)
#define PG8_SB(b, h) ((4 + (b) * 2 + (h)) * HTB)
#define PG8_STAGE(bufoff, gbase, voff) do { _Pragma("unroll") for (int _i = 0; _i < 2; ++_i) \
        __builtin_amdgcn_global_load_lds((const unsigned*)((const char*)(gbase) + (voff)[_i]), (PG8_LAS unsigned*)(lds + (bufoff) + ldsw + _i * 8192), 16, 0, 0); } while (0)
#define PG8_LDA(dst, b, h) do { _Pragma("unroll") for (int m = 0; m < 4; ++m) _Pragma("unroll") for (int k = 0; k < 2; ++k) dst[m][k] = *(const PG8_LAS bf16x8*)(lds + PG8_SA(b, h) + aoff + m * 2048 + k * 1024); } while (0)
#define PG8_LDB(dst, b, h) do { _Pragma("unroll") for (int n = 0; n < 2; ++n) _Pragma("unroll") for (int k = 0; k < 2; ++k) dst[n][k] = *(const PG8_LAS bf16x8*)(lds + PG8_SB(b, h) + boff + n * 2048 + k * 1024); } while (0)
#define PG8_MMA(ai, bj, At, Bt) do { __builtin_amdgcn_s_setprio(1); _Pragma("unroll") for (int m = 0; m < 4; ++m) _Pragma("unroll") for (int n = 0; n < 2; ++n) _Pragma("unroll") for (int k = 0; k < 2; ++k) \
        acc[ai][bj][m][n] = __builtin_amdgcn_mfma_f32_16x16x32_bf16(Bt[n][k], At[m][k], acc[ai][bj][m][n], 0, 0, 0); __builtin_amdgcn_s_setprio(0); } while (0)
#define PG8_WAIT_V(n) asm volatile("s_waitcnt vmcnt(" #n ")" ::: "memory")
#define PG8_WAIT_L(n) asm volatile("s_waitcnt lgkmcnt(" #n ")" ::: "memory")
#define PG8_BAR __builtin_amdgcn_s_barrier()
#define PG8_SCHED __builtin_amdgcn_sched_barrier(0)
    Unit cur, nxt; int ui = 0;
    if (!S.next(0, cur)) return;
    f32x4 acc[2][2][4][2];
#pragma unroll
    for (int a = 0; a < 2; ++a)
#pragma unroll
        for (int b = 0; b < 2; ++b)
#pragma unroll
            for (int m = 0; m < 4; ++m)
#pragma unroll
                for (int n = 0; n < 2; ++n) acc[a][b][m][n] = (f32x4){0.f, 0.f, 0.f, 0.f};
    bf16x8 At[4][2], B0[2][2], B1[2][2];
    const char* cA = (const char*)g.A + (size_t)cur.pm * tstep; const char* cB = (const char*)g.Bt + (size_t)cur.pn * tstep;
    S.a_ready(cur);
    if constexpr (SP2) {
        PG8_STAGE(PG8_SB(0, 0), cB, voffB); PG8_STAGE(PG8_SB(0, 1), cB + hstep, voffB); PG8_STAGE(PG8_SA(0, 0), cA, voffA); PG8_STAGE(PG8_SA(0, 1), cA + hstep, voffA);
        if (wr == 1) PG8_BAR;
        PG8_WAIT_V(2); PG8_BAR;
        PG8_STAGE(PG8_SB(1, 0), cB + kstep, voffB); PG8_STAGE(PG8_SA(1, 0), cA + kstep, voffA); PG8_STAGE(PG8_SB(1, 1), cB + hstep + kstep, voffB);
        PG8_WAIT_V(6); PG8_BAR;
    } else {
        PG8_STAGE(PG8_SB(0, 0), cB, voffB); PG8_STAGE(PG8_SA(0, 0), cA, voffA); PG8_STAGE(PG8_SB(0, 1), cB + hstep, voffB); PG8_STAGE(PG8_SA(0, 1), cA + hstep, voffA);
        if (wr == 1) PG8_BAR;
        PG8_WAIT_V(4); PG8_BAR;
        PG8_STAGE(PG8_SB(1, 0), cB + kstep, voffB); PG8_STAGE(PG8_SA(1, 0), cA + kstep, voffA); PG8_STAGE(PG8_SB(1, 1), cB + hstep + kstep, voffB);
        PG8_WAIT_V(6); PG8_BAR;
    }
    for (;;) {
        const bool has_next = S.next(ui + 1, nxt);
        const char* nA = has_next ? (const char*)g.A + (size_t)nxt.pm * tstep : cA; const char* nB = has_next ? (const char*)g.Bt + (size_t)nxt.pn * tstep : cB;
        for (int t = 0; t < nt; t += 2) {
            const bool last = (t == nt - 2);
            const size_t j1a = (g.jt && t + 1 >= g.jt) ? g.ja : 0, j2a = (g.jt && t + 2 >= g.jt) ? g.ja : 0, j2b = (g.jt && t + 2 >= g.jt) ? g.jb : 0;
            const char* a1 = cA + (size_t)(t + 1) * kstep + j1a;
            const char* a2 = last ? nA : cA + (size_t)(t + 2) * kstep + j2a; const char* b2 = last ? nB : cB + (size_t)(t + 2) * kstep + j2b;
            if constexpr (Epi::HAS_MID) { if (g.jt && t == g.jt) E.mid(acc, cur, wr, wc, fr, fq); }
            const char* a3 = a2 + kstep; const char* b3 = b2 + kstep;
            if (last && has_next) S.a_ready(nxt);
            if constexpr (SP2) {
            PG8_LDB(B0, 0, 0); PG8_LDB(B1, 0, 1); PG8_SCHED; PG8_LDA(At, 0, 0); PG8_STAGE(PG8_SA(1, 1), a1 + hstep, voffA);
            PG8_WAIT_V(8); PG8_WAIT_L(0); PG8_BAR; PG8_MMA(0, 0, At, B0); PG8_MMA(0, 1, At, B1); PG8_BAR; PG8_SCHED;
            PG8_LDA(At, 0, 1); PG8_STAGE(PG8_SB(0, 0), b2, voffB); PG8_STAGE(PG8_SB(0, 1), b2 + hstep, voffB); PG8_STAGE(PG8_SA(0, 0), a2, voffA);
            PG8_WAIT_V(8); PG8_WAIT_L(0); PG8_BAR; PG8_MMA(1, 0, At, B0); PG8_MMA(1, 1, At, B1); PG8_BAR; PG8_SCHED;
            PG8_LDB(B0, 1, 0); PG8_LDB(B1, 1, 1); PG8_SCHED; PG8_LDA(At, 1, 0); PG8_STAGE(PG8_SA(0, 1), a2 + hstep, voffA);
            PG8_WAIT_V(8); PG8_WAIT_L(0); PG8_BAR; PG8_MMA(0, 0, At, B0); PG8_MMA(0, 1, At, B1); PG8_BAR; PG8_SCHED;
            PG8_LDA(At, 1, 1); PG8_STAGE(PG8_SB(1, 0), b3, voffB); PG8_STAGE(PG8_SB(1, 1), b3 + hstep, voffB); PG8_STAGE(PG8_SA(1, 0), a3, voffA);
            PG8_WAIT_V(8); PG8_WAIT_L(0); PG8_BAR; PG8_MMA(1, 0, At, B0); PG8_MMA(1, 1, At, B1); PG8_BAR; PG8_SCHED;
            } else {
            PG8_LDB(B0, 0, 0); PG8_SCHED; PG8_LDA(At, 0, 0); PG8_STAGE(PG8_SA(1, 1), a1 + hstep, voffA);
            PG8_WAIT_L(8); PG8_BAR; PG8_WAIT_L(0); PG8_MMA(0, 0, At, B0); PG8_BAR; PG8_SCHED;
            PG8_LDB(B1, 0, 1); PG8_STAGE(PG8_SB(0, 0), b2, voffB);
            PG8_BAR; PG8_WAIT_L(0); PG8_MMA(0, 1, At, B1); PG8_BAR;
            PG8_LDA(At, 0, 1); PG8_STAGE(PG8_SA(0, 0), a2, voffA);
            PG8_BAR; PG8_WAIT_L(0); PG8_MMA(1, 0, At, B0); PG8_BAR; PG8_SCHED;
            PG8_STAGE(PG8_SB(0, 1), b2 + hstep, voffB);
            PG8_WAIT_V(6); PG8_BAR; PG8_MMA(1, 1, At, B1); PG8_BAR;
            PG8_LDB(B0, 1, 0); PG8_SCHED; PG8_LDA(At, 1, 0); PG8_STAGE(PG8_SA(0, 1), a2 + hstep, voffA);
            PG8_WAIT_L(8); PG8_BAR; PG8_WAIT_L(0); PG8_MMA(0, 0, At, B0); PG8_BAR; PG8_SCHED;
            PG8_LDB(B1, 1, 1); PG8_STAGE(PG8_SB(1, 0), b3, voffB);
            PG8_BAR; PG8_WAIT_L(0); PG8_MMA(0, 1, At, B1); PG8_BAR;
            PG8_LDA(At, 1, 1); PG8_STAGE(PG8_SA(1, 0), a3, voffA);
            PG8_BAR; PG8_WAIT_L(0); PG8_MMA(1, 0, At, B0); PG8_BAR; PG8_SCHED;
            PG8_STAGE(PG8_SB(1, 1), b3 + hstep, voffB);
            PG8_WAIT_V(6); PG8_BAR; PG8_MMA(1, 1, At, B1); PG8_BAR;
            }
        }
        if constexpr (ALIGN_EPI) { if (wr == 0) PG8_BAR; }
        if constexpr (!Epi::AFTER_DRAIN) { E(acc, cur, wr, wc, fr, fq); S.done(cur); }
        if (!has_next) break;
#pragma unroll
        for (int a = 0; a < 2; ++a)
#pragma unroll
            for (int b = 0; b < 2; ++b)
#pragma unroll
                for (int m = 0; m < 4; ++m)
#pragma unroll
                    for (int n = 0; n < 2; ++n) acc[a][b][m][n] = (f32x4){0.f, 0.f, 0.f, 0.f};
        cur = nxt; cA = nA; cB = nB; ++ui;
        if constexpr (ALIGN_EPI) { if (wr == 1) PG8_BAR; }
    }
    PG8_WAIT_V(0);
    if constexpr (!ALIGN_EPI) { if (wr == 0) PG8_BAR; }
    PG8_BAR;
    if constexpr (Epi::AFTER_DRAIN) { E.fused(acc, cur, wr, wc, fr, fq, lds, wid, lane); S.done(cur); }
#undef PG8_SA
#undef PG8_SB
#undef PG8_STAGE
#undef PG8_LDA
#undef PG8_LDB
#undef PG8_MMA
#undef PG8_WAIT_V
#undef PG8_WAIT_L
#undef PG8_BAR
#undef PG8_SCHED
}
}

namespace mk {
using pg8::bf16_t; using pg8::bf16x8; using pg8::f32x4; using pg8::u32x4; using pg8::u32x2; using pg8::s16x4; using pg8::pk2; using pg8::lo16; using pg8::hi16; using pg8::bf2f;
#define DI __device__ __forceinline__
#define MFMA16(a, b, c) __builtin_amdgcn_mfma_f32_16x16x32_bf16((a), (b), (c), 0, 0, 0)
constexpr int NT = 512;
#ifndef GEMM_SP2
#define GEMM_SP2 true
#endif
#ifndef GEMM_ALIGN
#define GEMM_ALIGN true
#endif
constexpr size_t MiB = (size_t)1 << 20;
constexpr size_t WS_CTL = 0, WS_MOD = 65536, WS_TAB = 512 * 1024, WS_AB = 1 * MiB, WS_AQ = 4 * MiB, WS_AKV = 20 * MiB, WS_DQKV = 29 * MiB, WS_DZ = 83 * MiB, WS_WIN = 99 * MiB, WS_H = 109 * MiB,
                 WS_PREP = 99 * MiB, WS_SC = 243 * MiB, WS_YD = 20 * MiB, WS_OF = 36 * MiB, WS_OB = 52 * MiB, WS_WBR = 76 * MiB, WS_WOUT = 78 * MiB, WS_WM1 = 68 * MiB, WS_WM2 = 247 * MiB,

                 WS_Y = 119 * MiB, WS_H2 = 4 * MiB, WS_ROWSQ = 320 * 1024, WS_BIAS = 384 * 1024, WS_ACT = 119 * MiB, WS_END = 255 * MiB;
constexpr int LDS_BYTES = 131072 + 1024 + 18432;
constexpr float LOG2E = 1.4426950408889634f;

struct Params { const float* in[21]; float* out; unsigned char* ws; };

DI bf16x8 pack8(const f32x4 a, const f32x4 b) { u32x4 r; r.x = pk2(a[0], a[1]); r.y = pk2(a[2], a[3]); r.z = pk2(b[0], b[1]); r.w = pk2(b[2], b[3]); return __builtin_bit_cast(bf16x8, r); }
DI bf16x8 pack8r(const f32x4 a, const f32x4 b) { u32x4 r; r.x = pk2(a[3], a[2]); r.y = pk2(a[1], a[0]); r.z = pk2(b[3], b[2]); r.w = pk2(b[1], b[0]); return __builtin_bit_cast(bf16x8, r); }
DI bf16_t f2bf(float v) { return (bf16_t)(pk2(v, 0.f) & 0xffffu); }
DI float silu(float v) { return v / (1.0f + __expf(-v)); }
#define LBAR() asm volatile("s_waitcnt lgkmcnt(0)\n\ts_barrier" ::: "memory")

struct ConvT { const float* src; bf16_t* dst; int ldsrc, ldk, k0, n0, mode; };
DI void conv_load(const ConvT& c, int tid, float (&r)[16]) {
#pragma unroll
    for (int i = 0; i < 16; ++i) { const int e = tid + NT * i, kk = e >> 7, nn = e & 127, n = c.n0 + nn; int sc = n;
        if (c.mode == 1) { if (n >= 2816 && n < 4864) { const int t = n - 2816, gt = t >> 8, j = t & 255; sc = j < 128 ? 2848 + 128 * gt + j : 3872 + 128 * gt + (j - 128); } else sc = n < 2816 ? n : (n < 4896 ? n - 2048 : -1); }
        r[i] = sc >= 0 ? c.src[(size_t)(c.k0 + kk) * c.ldsrc + sc] : 0.f; }
}
#define CONV_TILES(first, stride, ntiles, DEC, tile, HOOK) do { int tid_ = threadIdx.x; asm volatile("" : "+v"(tid_)); const int ctid = tid_; float cr[16]; int ct = (first); \
    if (ct < (ntiles)) { const ConvT c0 = DEC(ct); conv_load(c0, ctid, cr); } \
    for (; ct < (ntiles); ct += (stride)) { const ConvT cc = DEC(ct); \
        _Pragma("unroll") for (int i = 0; i < 16; ++i) { const int e = ctid + NT * i; (tile)[(e >> 7) * 129 + (e & 127)] = cr[i]; } \
        LBAR(); \
        if (ct + (stride) < (ntiles)) { const ConvT cn = DEC(ct + (stride)); conv_load(cn, ctid, cr); } \
        HOOK(cc, ct, ctid, tile); \
        { const int nn = ctid >> 2, ks = (ctid & 3) * 16; const float* t = (tile) + ks * 129 + nn; u32x4 w0, w1; \
          w0.x = pk2(t[0], t[129]); w0.y = pk2(t[258], t[387]); w0.z = pk2(t[516], t[645]); w0.w = pk2(t[774], t[903]); \
          w1.x = pk2(t[1032], t[1161]); w1.y = pk2(t[1290], t[1419]); w1.z = pk2(t[1548], t[1677]); w1.w = pk2(t[1806], t[1935]); \
          bf16_t* d = cc.dst + (size_t)(cc.n0 + nn) * cc.ldk + cc.k0 + ks; *(u32x4*)d = w0; *(u32x4*)(d + 8) = w1; } \
        LBAR(); } } while (0)
#define NO_HOOK(cc, ct, ctid, tile) do {} while (0)
#define BIAS_HOOK(cc, ct, ctid, tile) do { if ((ct) >= 256 && (ct) < 768) { const int hb_ = __builtin_amdgcn_readfirstlane((ctid) >> 6), hn_ = (ctid) & 63; const float* sh_ = (const float*)(P.ws + WS_MOD) + (size_t)hb_ * 6144 + 3072 + (cc).k0; float ps0_ = 0.f, ps1_ = 0.f; \
        _Pragma("unroll 16") for (int kk_ = 0; kk_ < 64; ++kk_) { const float sv_ = sh_[kk_]; ps0_ += (tile)[kk_ * 129 + hn_] * sv_; ps1_ += (tile)[kk_ * 129 + 64 + hn_] * sv_; } \
        float* bp_ = (float*)(P.ws + WS_BIAS) + hb_ * 4096 + (cc).n0 + hn_; atomicAdd(bp_, ps0_); atomicAdd(bp_ + 64, ps1_); } } while (0)
DI ConvT dec_win(const Params& P, int t) { ConvT c; c.src = P.in[7]; c.dst = (bf16_t*)(P.ws + WS_WIN); c.ldsrc = 4896; c.ldk = 1024; c.k0 = (t & 15) * 64; c.n0 = (t >> 4) * 128; c.mode = 1; return c; }
DI ConvT dec_rest(const Params& P, int t) { ConvT c; c.mode = 0;
    if (t < 128) { const int br = t >> 6, tt = t & 63; c.src = P.in[15 + br]; c.dst = (bf16_t*)(P.ws + WS_WBR) + (size_t)br * 1024 * 512; c.ldsrc = 1024; c.ldk = 512; c.k0 = (tt & 7) * 64; c.n0 = (tt >> 3) * 128; }
    else if (t < 256) { const int tt = t - 128; c.src = P.in[17]; c.dst = (bf16_t*)(P.ws + WS_WOUT); c.ldsrc = 1024; c.ldk = 1024; c.k0 = (tt & 15) * 64; c.n0 = (tt >> 4) * 128; }
    else if (t < 768) { const int tt = t - 256; c.src = P.in[19]; c.dst = (bf16_t*)(P.ws + WS_WM1); c.ldsrc = 4096; c.ldk = 1024; c.k0 = (tt & 15) * 64; c.n0 = (tt >> 4) * 128; }
    else { const int tt = t - 768; c.src = P.in[20]; c.dst = (bf16_t*)(P.ws + WS_WM2); c.ldsrc = 1024; c.ldk = 4096; c.k0 = (tt & 63) * 64; c.n0 = (tt >> 6) * 128; }
    return c; }
DI void mod_item(const Params& P, int item, float* sil) {
    const int tid = threadIdx.x, ns = item % 12, ksl = item / 12;
    if (tid < 144) { const int r = tid >> 4, kk = tid & 15; const float v = r < 8 ? P.in[1][r * 1024 + ksl * 16 + kk] : P.in[3][ksl * 16 + kk]; sil[tid] = v / (1.0f + expf(-v)); }
    const int n = ns * 512 + tid; const float* w = P.in[4] + (size_t)(ksl * 16) * 6144 + n; float wv[16];
#pragma unroll
    for (int kk = 0; kk < 16; ++kk) wv[kk] = w[(size_t)kk * 6144];
    __syncthreads();
    float acc[9];
#pragma unroll
    for (int r = 0; r < 9; ++r) acc[r] = 0.f;
#pragma unroll
    for (int kk = 0; kk < 16; ++kk)
#pragma unroll
        for (int r = 0; r < 9; ++r) acc[r] += sil[r * 16 + kk] * wv[kk];
    float* mod = (float*)(P.ws + WS_MOD); const float bias = ksl == 0 ? P.in[5][n] : 0.f;
#pragma unroll
    for (int r = 0; r < 9; ++r) atomicAdd(mod + r * 6144 + n, acc[r] + bias);
    __syncthreads();
}

DI void modnorm_rows(const float* src_lat, const float* src_ctx, int nrows, const float* g, const float* mod, int sh_off, int sc_off, bf16_t* dst) {
    const int wave = threadIdx.x >> 6, lane = threadIdx.x & 63; const int stride = gridDim.x * 8;
    int row = blockIdx.x * 8 + wave; f32x4 v[4];
    if (row < nrows) { const float* src = row < 16384 ? src_lat + (size_t)row * 1024 : src_ctx + (size_t)(row - 16384) * 1024;
#pragma unroll
        for (int j = 0; j < 4; ++j) v[j] = *(const f32x4*)(src + j * 256 + lane * 4); }
    for (; row < nrows; row += stride) {
        const int nrow = row + stride; f32x4 vn[4];
#pragma unroll
        for (int j = 0; j < 4; ++j) vn[j] = v[j];
        if (nrow < nrows) { const float* src = nrow < 16384 ? src_lat + (size_t)nrow * 1024 : src_ctx + (size_t)(nrow - 16384) * 1024;
#pragma unroll
            for (int j = 0; j < 4; ++j) vn[j] = *(const f32x4*)(src + j * 256 + lane * 4); }
        const float* mr = mod + (size_t)(row < 16384 ? (row >> 11) : 8) * 6144; float ss = 0.f;
#pragma unroll
        for (int j = 0; j < 4; ++j) ss += v[j][0] * v[j][0] + v[j][1] * v[j][1] + v[j][2] * v[j][2] + v[j][3] * v[j][3];
#pragma unroll
        for (int off = 32; off >= 1; off >>= 1) ss += __shfl_xor(ss, off);
        const float rstd = rsqrtf(ss * (1.0f / 1024.0f) + 1e-6f);
#pragma unroll
        for (int j = 0; j < 4; ++j) { const int col = j * 256 + lane * 4; const f32x4 gg = *(const f32x4*)(g + col), sc = *(const f32x4*)(mr + sc_off + col), sh = *(const f32x4*)(mr + sh_off + col);
            const f32x4 hh = v[j] * rstd * gg * (sc + 1.0f) + sh; u32x2 w; w.x = pk2(hh[0], hh[1]); w.y = pk2(hh[2], hh[3]); *(u32x2*)(dst + (size_t)row * 1024 + col) = w; }
#pragma unroll
        for (int j = 0; j < 4; ++j) v[j] = vn[j];
    }
}

DI int frag_idx(int row, int k) { return ((((row >> 4) * 2 + (k >> 5)) * 64) + (((k & 15) >> 2) * 16 + (row & 15))) * 8 + ((k >> 4) & 1) * 4 + (k & 3); }
DI float silu_fast(float v) { return v * __builtin_amdgcn_rcpf(1.0f + __expf(-v)); }
DI void prep_phase(const Params& P, unsigned char* smem) {
    int tid_ = threadIdx.x; asm volatile("" : "+v"(tid_)); const int tid = tid_, half = tid >> 8, hid = tid & 255, lane = tid & 63, w4 = (tid >> 6) & 3, dir = half;
    const int r2 = half, r4a = 2 + half;
    unsigned char* hb = smem + half * 64256;
    bf16_t* sQ = (bf16_t*)hb; bf16_t* sK = sQ + 64 * 72; bf16_t* sV = sK + 64 * 72; bf16_t* sAn = sV + 64 * 72; bf16_t* sXt = sAn + 64 * 72; float* sAd = (float*)(hb + 55296); bf16_t* sD = (bf16_t*)(hb + 60416);
    float* sG = (float*)(hb + 63488); float* sBeta = sG + 64; float* sEG = sBeta + 64;
    const bf16_t* DQKV = (const bf16_t*)(P.ws + WS_DQKV); const float* AB = (const float*)(P.ws + WS_AB);
    float* sCW = (float*)(smem + 132096);
    for (int e = tid; e < 1152; e += NT) *(f32x4*)(sCW + e * 4) = *(const f32x4*)(P.in[11] + e * 4);
    const float r_alog = P.in[12][lane & 15], r_dtb = P.in[13][lane & 15];
    LBAR();
    u32x4 ra[3][3]; float rda = 0.f, rdb = 0.f;
#define PREP_LOAD(it) do { const int ci_ = (it) % 36, bh_ = (it) / 36, h_ = bh_ & 7, b_ = bh_ >> 3; const bool lat_ = ci_ >= 4; \
        const int sb_ = lat_ ? b_ * 2048 : 16384 + b_ * 256, sl_ = lat_ ? 2048 : 256, t0_ = lat_ ? (ci_ - 4) * 64 : ci_ * 64, t_ = t0_ + (tid >> 3); \
        _Pragma("unroll") for (int tap = 0; tap < 3; ++tap) { int tt = t_ + tap - 1; tt = tt < 0 ? 0 : (tt >= sl_ ? sl_ - 1 : tt); const bf16_t* pr = DQKV + (size_t)(sb_ + tt) * 1536 + h_ * 64 + (tid & 7) * 8; \
            _Pragma("unroll") for (int T = 0; T < 3; ++T) ra[T][tap] = *(const u32x4*)(pr + T * 512); } \
        if (w4 == r2) { const int tl_ = t0_ + (dir ? 63 - lane : lane); const float* ab_ = AB + (size_t)(sb_ + tl_) * 32; const int j_ = dir * 8 + h_; rda = ab_[j_]; rdb = ab_[16 + j_]; } } while (0)
    if ((int)blockIdx.x < 2304) PREP_LOAD((int)blockIdx.x);
    for (int item = blockIdx.x; item < 2304; item += gridDim.x) {
    const int ci = item % 36, bh = item / 36, h = bh & 7; const bool lat = ci >= 4;
    const int seqlen = lat ? 2048 : 256, t0 = lat ? (ci - 4) * 64 : ci * 64;
    unsigned char* rec = P.ws + WS_PREP + (size_t)item * 65536;
    bf16_t* Wp = (bf16_t*)(rec + 16384 + dir * 24576); bf16_t* Up = Wp + 4096; bf16_t* Ip = Up + 4096;
    float* sc = (float*)(P.ws + WS_SC) + (size_t)(item * 2 + dir) * 192;
    { const int c = tid >> 3, seg = tid & 7, t = t0 + c;
      float mk[3]; mk[0] = t - 1 >= 0 ? 1.0f : 0.0f; mk[1] = 1.0f; mk[2] = t + 1 < seqlen ? 1.0f : 0.0f;
#pragma unroll
      for (int T = 0; T < 3; ++T) {
          float y[8];
#pragma unroll
          for (int e = 0; e < 8; ++e) y[e] = 0.f;
          const float* cw = sCW + T * 512 + h * 64 + seg * 8;
#pragma unroll
          for (int tap = 0; tap < 3; ++tap) { const u32x4 a0 = ra[T][tap]; const float* w = cw + tap * 1536; const float m = mk[tap];
              const f32x4 w0 = *(const f32x4*)w * m, w1 = *(const f32x4*)(w + 4) * m;
              y[0] += w0[0] * lo16(a0.x); y[1] += w0[1] * hi16(a0.x); y[2] += w0[2] * lo16(a0.y); y[3] += w0[3] * hi16(a0.y); y[4] += w1[0] * lo16(a0.z); y[5] += w1[1] * hi16(a0.z); y[6] += w1[2] * lo16(a0.w); y[7] += w1[3] * hi16(a0.w); }
#pragma unroll
          for (int e = 0; e < 8; ++e) { y[e] = silu_fast(y[e]); if (T == 0 && !lat) y[e] = 0.f; }
          if (T < 2) { float ss = 0.f;
#pragma unroll
              for (int e = 0; e < 8; ++e) ss += y[e] * y[e];
              ss += __shfl_xor(ss, 1); ss += __shfl_xor(ss, 2); ss += __shfl_xor(ss, 4); const float sn = rsqrtf(ss + 1e-6f) * (T == 0 ? 0.125f : 1.0f);
#pragma unroll
              for (int e = 0; e < 8; ++e) y[e] *= sn; }
          u32x4 o0; o0.x = pk2(y[0], y[1]); o0.y = pk2(y[2], y[3]); o0.z = pk2(y[4], y[5]); o0.w = pk2(y[6], y[7]);
          const int toff = T * 64 * 72 + seg * 8;
          *(u32x4*)((bf16_t*)smem + toff + c * 72) = o0; *(u32x4*)((bf16_t*)(smem + 64256) + toff + (63 - c) * 72) = o0;
      } }
    if (w4 == r2) { const int c = lane; const int j = dir * 8 + h;
        const float xa = rda + __shfl(r_dtb, j); const float sp = xa > 20.f ? xa : log1pf(__expf(xa));
        float G = -__expf(__shfl(r_alog, j)) * sp; const float beta = __builtin_amdgcn_rcpf(1.0f + __expf(-rdb));
#pragma unroll
        for (int off = 1; off < 64; off <<= 1) { const float v = __shfl_up(G, off); if (lane >= off) G += v; }
        const float gl = __shfl(G, 63), eg = __expf(G);
        sG[c] = G; sBeta[c] = beta; sEG[c] = eg; sc[c] = eg; sc[64 + c] = __expf(gl - G); if (c == 0) sc[128] = __expf(gl); }
    LBAR();
    if (item + (int)gridDim.x < 2304) PREP_LOAD(item + (int)gridDim.x);
    { const int r16 = lane & 15, q = lane >> 4, mb = w4; f32x4 kk[4], kq[4];
#pragma unroll
      for (int nb = 0; nb < 4; ++nb) { kk[nb] = (f32x4){0.f, 0.f, 0.f, 0.f}; kq[nb] = (f32x4){0.f, 0.f, 0.f, 0.f}; }
#pragma unroll
      for (int ks = 0; ks < 2; ++ks) { const bf16x8 ak = *(const bf16x8*)(sK + (16 * mb + r16) * 72 + 32 * ks + 8 * q);
#pragma unroll
          for (int nb = 0; nb < 4; ++nb) { const bf16x8 bk = *(const bf16x8*)(sK + (16 * nb + r16) * 72 + 32 * ks + 8 * q), bq = *(const bf16x8*)(sQ + (16 * nb + r16) * 72 + 32 * ks + 8 * q);
              kk[nb] = MFMA16(ak, bk, kk[nb]); kq[nb] = MFMA16(ak, bq, kq[nb]); } }
#pragma unroll
      for (int nb = 0; nb < 4; ++nb) {
#pragma unroll
          for (int i = 0; i < 4; ++i) { const int ri = 16 * mb + 4 * q + i, cj = 16 * nb + r16; float a = 0.f;
              if (nb <= mb) a = cj < ri ? sBeta[ri] * __expf(fminf(sG[ri] - sG[cj], 0.f)) * kk[nb][i] : 0.f;
              sAn[ri * 72 + cj] = f2bf(-a); if (nb == mb) sAd[(mb * 16 + 4 * q + i) * 20 + r16] = a; }
          if (lat && nb < mb) { *(u32x2*)(Ip + frag_idx(16 * nb + r16, 16 * mb + 4 * q)) = (u32x2){0u, 0u}; }
          if (lat && nb >= mb) { const int ri = 16 * nb + r16; const float gi = sG[ri]; float iv[4];
#pragma unroll
              for (int i = 0; i < 4; ++i) { const int cj = 16 * mb + 4 * q + i; iv[i] = cj <= ri ? __expf(fminf(gi - sG[cj], 0.f)) * kq[nb][i] : 0.f; }
              u32x2 wv; wv.x = pk2(iv[0], iv[1]); wv.y = pk2(iv[2], iv[3]); *(u32x2*)(Ip + frag_idx(ri, 16 * mb + 4 * q)) = wv; } }
    }
    LBAR();
    if (w4 == r4a) { const int bb = lane >> 4, j = lane & 15; float x[16];
        typedef __attribute__((address_space(3))) const f32x4* lcf4; const lcf4 ad = (lcf4)(sAd + bb * 16 * 20);
        x[0] = j == 0 ? 1.0f : 0.0f;
#define DIAG_ROWS(lo, hi) do { f32x4 ar[(hi) - (lo)][4]; \
        _Pragma("unroll") for (int i = (lo); i < (hi); ++i) _Pragma("unroll") for (int k4 = 0; k4 < i; k4 += 4) ar[i - (lo)][k4 >> 2] = ad[i * 5 + (k4 >> 2)]; \
        _Pragma("unroll") for (int i = (lo); i < (hi); ++i) { float sv = i == j ? 1.0f : 0.0f; \
            _Pragma("unroll") for (int k4 = 0; k4 < i; k4 += 4) { const f32x4 a = ar[i - (lo)][k4 >> 2]; sv -= a[0] * x[k4]; if (k4 + 1 < i) sv -= a[1] * x[k4 + 1]; if (k4 + 2 < i) sv -= a[2] * x[k4 + 2]; if (k4 + 3 < i) sv -= a[3] * x[k4 + 3]; } \
            x[i] = sv; } } while (0)
        DIAG_ROWS(1, 9); DIAG_ROWS(9, 13); DIAG_ROWS(13, 16);
#undef DIAG_ROWS
#pragma unroll
        for (int i = 0; i < 16; ++i) sD[(bb * 16 + i) * 24 + j] = f2bf(x[i]);
    } else { const int rk = (w4 - (w4 > r4a ? 1 : 0)) * 64 + lane;
      if (dir == 0) { bf16_t* Qf = (bf16_t*)rec; bf16_t* KTf = Qf + 4096;
        for (int fid = rk; fid < 512; fid += 192) { const int fmb = fid >> 7, ks = (fid >> 6) & 1, lf = fid & 63, qf = lf >> 4, fr = lf & 15; const int row = 16 * fmb + fr, k0 = 32 * ks + 4 * qf;
            if (lat) { const u32x2 a = *(const u32x2*)(sQ + row * 72 + k0), bq = *(const u32x2*)(sQ + row * 72 + k0 + 16); u32x4 wv; wv.x = a.x; wv.y = a.y; wv.z = bq.x; wv.w = bq.y; *(u32x4*)(Qf + fid * 8) = wv; }
            u32x4 wv; const bf16_t* kc = sK + row;
            wv.x = (unsigned)kc[(k0 + 0) * 72] | ((unsigned)kc[(k0 + 1) * 72] << 16); wv.y = (unsigned)kc[(k0 + 2) * 72] | ((unsigned)kc[(k0 + 3) * 72] << 16);
            wv.z = (unsigned)kc[(k0 + 16) * 72] | ((unsigned)kc[(k0 + 17) * 72] << 16); wv.w = (unsigned)kc[(k0 + 18) * 72] | ((unsigned)kc[(k0 + 19) * 72] << 16);
            *(u32x4*)(KTf + fid * 8) = wv; } }
      for (int o = rk; o < 1024; o += 192) *(u32x4*)(sXt + (o >> 3) * 72 + (o & 7) * 8) = (u32x4){0u, 0u, 0u, 0u};
    }
    LBAR();
    { const int r16 = lane & 15, q = lane >> 4;
#pragma unroll
      for (int bb = 0; bb < 4; ++bb) {
          f32x4 be;
#pragma unroll
          for (int i = 0; i < 4; ++i) { const int ri = 16 * bb + 4 * q + i; be[i] = w4 < 2 ? sBeta[ri] * sEG[ri] : sBeta[ri]; }
          const u32x2 dq = *(const u32x2*)(sD + (bb * 16 + r16) * 24 + 4 * q); u32x4 dfr; dfr.x = dq.x; dfr.y = dq.y; dfr.z = 0u; dfr.w = 0u;
#pragma unroll
          for (int t = 0; t < 2; ++t) { const int n0 = 32 * w4 + 16 * t + r16; const bf16_t* rsrc = (w4 < 2 ? sK + n0 : sV + (n0 - 64)) + (16 * bb + 4 * q) * 72;
              f32x4 acc; acc[0] = be[0] * bf2f(rsrc[0]); acc[1] = be[1] * bf2f(rsrc[72]); acc[2] = be[2] * bf2f(rsrc[144]); acc[3] = be[3] * bf2f(rsrc[216]);
#pragma unroll
              for (int ks = 0; ks < (bb + 1) / 2; ++ks) acc = MFMA16(*(const bf16x8*)(sAn + (16 * bb + r16) * 72 + 32 * ks + 8 * q), *(const bf16x8*)(sXt + n0 * 72 + 32 * ks + 8 * q), acc);
              u32x4 yb; yb.x = pk2(acc[0], acc[1]); yb.y = pk2(acc[2], acc[3]); yb.z = 0u; yb.w = 0u;
              const f32x4 z = MFMA16(__builtin_bit_cast(bf16x8, dfr), __builtin_bit_cast(bf16x8, yb), ((f32x4){0.f, 0.f, 0.f, 0.f}));
              u32x2 zw; zw.x = pk2(z[0], z[1]); zw.y = pk2(z[2], z[3]);
              *(u32x2*)(sXt + n0 * 72 + 16 * bb + 4 * q) = zw;
              if (w4 >= 2) { const int vs = 2 * (w4 - 2) + t; *(u32x2*)(Up + ((vs * 4 + bb) * 64 + lane) * 4) = zw; } }
          asm volatile("s_waitcnt lgkmcnt(0)" ::: "memory");
      }
      if (w4 < 2) {
#pragma unroll
          for (int mb = 0; mb < 4; ++mb) { const bf16_t* xc = sXt + (32 * w4 + 4 * q) * 72 + 16 * mb + r16; u32x4 wv;
              wv.x = ((unsigned)xc[0] | ((unsigned)xc[72] << 16)) ^ 0x80008000u; wv.y = ((unsigned)xc[144] | ((unsigned)xc[216] << 16)) ^ 0x80008000u;
              wv.z = ((unsigned)xc[16 * 72] | ((unsigned)xc[17 * 72] << 16)) ^ 0x80008000u; wv.w = ((unsigned)xc[18 * 72] | ((unsigned)xc[19 * 72] << 16)) ^ 0x80008000u;
              *(u32x4*)(Wp + ((mb * 2 + w4) * 64 + lane) * 8) = wv; } }
    }
    LBAR();
    }
}

DI void qk_normrope(const Params& P) {
    bf16_t* AQ = (bf16_t*)(P.ws + WS_AQ); bf16_t* AKV = (bf16_t*)(P.ws + WS_AKV); const float* TAB = (const float*)(P.ws + WS_TAB);
    for (int task = blockIdx.x * NT + threadIdx.x; task < 131072 + 36864; task += gridDim.x * NT) {
        bf16_t* ptr; const float* g; bool rope; int pos; float extra;
        if (task < 131072) { const int row = task >> 3, hd = task & 7; ptr = AQ + (size_t)row * 512 + hd * 64; g = P.in[8]; rope = true; pos = row & 2047; extra = 0.125f * LOG2E; }
        else { const int t2 = task - 131072, row = t2 >> 1, hd = t2 & 1; ptr = AKV + (size_t)row * 256 + hd * 64; g = P.in[9]; rope = row < 16384; pos = row & 2047; extra = 1.0f; }
        float v[64]; float ss = 0.f;
#pragma unroll
        for (int j = 0; j < 8; ++j) { const u32x4 a = *(const u32x4*)(ptr + j * 8); v[j * 8 + 0] = lo16(a.x); v[j * 8 + 1] = hi16(a.x); v[j * 8 + 2] = lo16(a.y); v[j * 8 + 3] = hi16(a.y); v[j * 8 + 4] = lo16(a.z); v[j * 8 + 5] = hi16(a.z); v[j * 8 + 6] = lo16(a.w); v[j * 8 + 7] = hi16(a.w); }
#pragma unroll
        for (int d = 0; d < 64; ++d) ss += v[d] * v[d];
        const float rs = rsqrtf(ss * (1.0f / 64.0f) + 1e-6f);
#pragma unroll
        for (int d = 0; d < 64; ++d) v[d] = v[d] * rs * g[d];
        if (rope) { const float* tr = TAB + (size_t)(pos >> 6) * 32; const float* tc = TAB + (size_t)(pos & 63) * 32;
#pragma unroll
            for (int f = 0; f < 16; ++f) { const float c1 = tr[2 * f], s1 = tr[2 * f + 1], c2 = tc[2 * f], s2 = tc[2 * f + 1];
                const float a1 = v[f], a2 = v[16 + f], b1 = v[32 + f], b2 = v[48 + f];
                v[f] = a1 * c1 - a2 * s1; v[16 + f] = a1 * s1 + a2 * c1; v[32 + f] = b1 * c2 - b2 * s2; v[48 + f] = b1 * s2 + b2 * c2; } }
#pragma unroll
        for (int j = 0; j < 8; ++j) { u32x4 w; w.x = pk2(v[j * 8] * extra, v[j * 8 + 1] * extra); w.y = pk2(v[j * 8 + 2] * extra, v[j * 8 + 3] * extra); w.z = pk2(v[j * 8 + 4] * extra, v[j * 8 + 5] * extra); w.w = pk2(v[j * 8 + 6] * extra, v[j * 8 + 7] * extra);
            *(u32x4*)(ptr + j * 8) = w; }
    }
}

#define SC_LAS __attribute__((address_space(3)))
DI int scan_chunk(int dir, int p) { return dir == 0 ? p : (p < 4 ? 3 - p : 39 - p); }
DI void scan_block(const Params& P, int sb, unsigned char* smem) {
    int tid_ = threadIdx.x; asm volatile("" : "+v"(tid_)); const int tid = tid_, lane = tid & 63, r16 = lane & 15, q = lane >> 4;
    const int w = __builtin_amdgcn_readfirstlane(tid >> 6), pair = sb >> 1, dir = sb & 1; const int b = pair >> 3, h = pair & 7;
    SC_LAS unsigned char* L = (SC_LAS unsigned char*)smem;
    const unsigned char* prep = P.ws + WS_PREP + (size_t)pair * 36 * 65536;
    __syncthreads();
    if (w >= 4) {
        const int m = w - 4; const int moff = m == 0 ? 16384 + dir * 24576 : (m == 1 ? 0 : (m == 2 ? 32768 + dir * 24576 : 8192));
#define SCAN_DMA(pp) do { const unsigned char* src_ = prep + (size_t)scan_chunk(dir, (pp)) * 65536 + moff + lane * 16; SC_LAS unsigned char* dst_ = L + ((pp) % 3) * 32768 + m * 8192; \
        _Pragma("unroll") for (int i_ = 0; i_ < 8; ++i_) __builtin_amdgcn_global_load_lds((const unsigned*)(src_ + i_ * 1024), (SC_LAS unsigned*)(dst_ + i_ * 1024), 16, 0, 0); } while (0)
        SCAN_DMA(0); SCAN_DMA(1);
        for (int p = 0; p < 36; ++p) {
            if (p + 1 < 36) asm volatile("s_waitcnt vmcnt(8)" ::: "memory"); else asm volatile("s_waitcnt vmcnt(0)" ::: "memory");
            __builtin_amdgcn_s_barrier();
            if (p + 2 < 36) SCAN_DMA(p + 2);
        }
#undef SCAN_DMA
    } else {
        const int vs = w; bf16_t* Oout = (bf16_t*)(P.ws + (dir ? WS_OB : WS_OF)); const float* scb = (const float*)(P.ws + WS_SC) + (size_t)pair * 36 * 2 * 192 + dir * 192;
#define SCAN_LDREG(pp, Ur, Eg, Tl, Egl) do { const int ci_ = scan_chunk(dir, (pp)); const bf16_t* Up_ = (const bf16_t*)(prep + (size_t)ci_ * 65536 + 16384 + dir * 24576 + 8192); const float* sc_ = scb + (size_t)ci_ * 384; \
        _Pragma("unroll") for (int mb_ = 0; mb_ < 4; ++mb_) { Ur[mb_] = *(const u32x2*)(Up_ + ((vs * 4 + mb_) * 64 + lane) * 4); Eg[mb_] = *(const f32x4*)(sc_ + 16 * mb_ + 4 * q); Tl[mb_] = *(const f32x4*)(sc_ + 64 + 16 * mb_ + 4 * q); } \
        Egl = sc_[128]; } while (0)
        f32x4 S[4];
#pragma unroll
        for (int r = 0; r < 4; ++r) S[r] = (f32x4){0.f, 0.f, 0.f, 0.f};
        u32x2 Uc[4]; f32x4 Egc[4], Tlc[4]; float Eglc; u32x2 opk[4]; int otb = -1;
#pragma unroll
        for (int mb = 0; mb < 4; ++mb) { opk[mb].x = 0u; opk[mb].y = 0u; }
#define SCAN_OSTORE() do { _Pragma("unroll") for (int mb_ = 0; mb_ < 4; ++mb_) { const int cp_ = 16 * mb_ + 4 * q; bf16_t* ob_ = Oout + (size_t)otb * 512 + h * 64 + 16 * vs + r16; const int st_ = dir ? -512 : 512; ob_ += (dir ? 63 - cp_ : cp_) * 512; \
        ob_[0] = (bf16_t)(opk[mb_].x & 0xffffu); ob_[st_] = (bf16_t)(opk[mb_].x >> 16); ob_[2 * st_] = (bf16_t)(opk[mb_].y & 0xffffu); ob_[3 * st_] = (bf16_t)(opk[mb_].y >> 16); } } while (0)
        SCAN_LDREG(0, Uc, Egc, Tlc, Eglc);
        for (int p = 0; p < 36; ++p) {
            asm volatile("s_waitcnt vmcnt(0)" ::: "memory"); __builtin_amdgcn_s_barrier(); asm volatile("" ::: "memory");
            if (otb >= 0) { SCAN_OSTORE(); otb = -1; }
            u32x2 Un[4]; f32x4 Egn[4], Tln[4]; float Egln = 0.f;
#pragma unroll
            for (int mb = 0; mb < 4; ++mb) { Un[mb] = Uc[mb]; Egn[mb] = Egc[mb]; Tln[mb] = Tlc[mb]; }
            if (p + 1 < 36) { SCAN_LDREG(p + 1, Un, Egn, Tln, Egln); }
            const int ci = scan_chunk(dir, p); const bool lat = ci >= 4;
            const SC_LAS unsigned char* B0 = L + (p % 3) * 32768;
#define SCAN_FRAG(m, idx) (*(const SC_LAS bf16x8*)(B0 + (m) * 8192 + (idx) * 16))
            bf16x8 Sb[2]; Sb[0] = pack8(S[0], S[1]); Sb[1] = pack8(S[2], S[3]);
            f32x4 u[4];
#pragma unroll
            for (int mb = 0; mb < 4; ++mb) { u[mb][0] = lo16(Uc[mb].x); u[mb][1] = hi16(Uc[mb].x); u[mb][2] = lo16(Uc[mb].y); u[mb][3] = hi16(Uc[mb].y); }
#pragma unroll
            for (int mb = 0; mb < 4; ++mb)
#pragma unroll
                for (int ks = 0; ks < 2; ++ks) u[mb] = MFMA16(SCAN_FRAG(0, (mb * 2 + ks) * 64 + lane), Sb[ks], u[mb]);
            if (lat) {
                f32x4 o[4];
#pragma unroll
                for (int mb = 0; mb < 4; ++mb) { o[mb] = (f32x4){0.f, 0.f, 0.f, 0.f};
#pragma unroll
                    for (int ks = 0; ks < 2; ++ks) { const int qi = dir ? (((3 - mb) * 2 + ks) * 64 + (lane ^ 15)) : ((mb * 2 + ks) * 64 + lane); o[mb] = MFMA16(SCAN_FRAG(1, qi), Sb[ks], o[mb]); }
                    o[mb] = o[mb] * Egc[mb]; }
                bf16x8 ub[2]; ub[0] = pack8(u[0], u[1]); ub[1] = pack8(u[2], u[3]);
#pragma unroll
                for (int mb = 0; mb < 4; ++mb)
#pragma unroll
                    for (int ks = 0; ks < 2; ++ks) o[mb] = MFMA16(SCAN_FRAG(2, (mb * 2 + ks) * 64 + lane), ub[ks], o[mb]);
                otb = b * 2048 + (ci - 4) * 64;
#pragma unroll
                for (int mb = 0; mb < 4; ++mb) { opk[mb].x = pk2(o[mb][0], o[mb][1]); opk[mb].y = pk2(o[mb][2], o[mb][3]); }
            }
            f32x4 u2[4];
#pragma unroll
            for (int mb = 0; mb < 4; ++mb) u2[mb] = u[mb] * Tlc[mb];
            bf16x8 ub2[2]; int kl;
            if (dir == 0) { ub2[0] = pack8(u2[0], u2[1]); ub2[1] = pack8(u2[2], u2[3]); kl = lane; }
            else { ub2[0] = pack8r(u2[3], u2[2]); ub2[1] = pack8r(u2[1], u2[0]); kl = (3 - q) * 16 + r16; }
#pragma unroll
            for (int r = 0; r < 4; ++r) { S[r] = S[r] * Eglc;
#pragma unroll
                for (int ks = 0; ks < 2; ++ks) S[r] = MFMA16(SCAN_FRAG(3, (r * 2 + ks) * 64 + kl), ub2[ks], S[r]); }
#pragma unroll
            for (int mb = 0; mb < 4; ++mb) { Uc[mb] = Un[mb]; Egc[mb] = Egn[mb]; Tlc[mb] = Tln[mb]; }
            Eglc = Egln;
        }
        if (otb >= 0) { SCAN_OSTORE(); }
#undef SCAN_OSTORE
#undef SCAN_FRAG
#undef SCAN_LDREG
    }
    asm volatile("s_waitcnt vmcnt(0) lgkmcnt(0)" ::: "memory"); __syncthreads();
}

DI void attn_phase(const Params& P, unsigned char* smem, unsigned* ctr, volatile int* sItem) {
    int tid_ = threadIdx.x; asm volatile("" : "+v"(tid_)); const int tid = tid_, w = tid >> 6, lane = tid & 63, r16 = lane & 15, q = lane >> 4;
    bf16_t* AQ = (bf16_t*)(P.ws + WS_AQ); const bf16_t* AKV = (const bf16_t*)(P.ws + WS_AKV);
    bf16_t* sK = (bf16_t*)smem; bf16_t* sVt = sK + 2 * 64 * 72;
    const int key = tid >> 3, seg = tid & 7;
    LBAR(); if (tid == 0) sItem[0] = (int)atomicAdd(ctr, 1u); LBAR();
    int item = sItem[0]; if (item >= 1024) return;
    bf16x8 Qb[2]; u32x4 kreg, vreg;
#define ATT_FIRST(it, Q0, Q1) do { const int b_ = (it) >> 7, qb_ = ((it) >> 3) & 15, hd_ = (it) & 7, q0_ = qb_ * 128, lo_ = q0_ - 128 < 0 ? 0 : q0_ - 128; \
        const bf16_t* qr_ = AQ + (size_t)(b_ * 2048 + q0_ + 16 * w + r16) * 512 + hd_ * 64; Q0 = *(const bf16x8*)(qr_ + 8 * q); Q1 = *(const bf16x8*)(qr_ + 32 + 8 * q); \
        const bf16_t* kp_ = AKV + (size_t)(b_ * 2048 + lo_ + key) * 256 + (hd_ >> 2) * 64 + seg * 8; kreg = *(const u32x4*)kp_; vreg = *(const u32x4*)(kp_ + 128); } while (0)
    ATT_FIRST(item, Qb[0], Qb[1]);
    for (;;) {
        if (tid == 0) sItem[1] = (int)atomicAdd(ctr, 1u);
        const int b = item >> 7, qb = (item >> 3) & 15, head = item & 7, g = head >> 2, q0 = qb * 128;
        const int qpos = q0 + 16 * w + r16; bf16_t* qrow = AQ + (size_t)(b * 2048 + qpos) * 512 + head * 64;
        float m = P.in[10][head] * LOG2E, l = q == 0 ? 1.0f : 0.0f; f32x4 O[4];
#pragma unroll
        for (int mb = 0; mb < 4; ++mb) O[mb] = (f32x4){0.f, 0.f, 0.f, 0.f};
        const int lo = q0 - 128 < 0 ? 0 : q0 - 128, hi = q0 + 256 > 2048 ? 2048 : q0 + 256, nloc = (hi - lo) >> 6, ntile = nloc + 4;
        int nxt = 1024; bf16x8 Qn[2]; Qn[0] = Qb[0]; Qn[1] = Qb[1];
        for (int j = 0; j < ntile; ++j) {
            const int buf = j & 1; bf16_t* bK = sK + buf * 64 * 72; bf16_t* bV = sVt + buf * 64 * 76;
            *(u32x4*)(bK + key * 72 + seg * 8) = kreg;
            { bf16_t* vp = bV + (seg * 8) * 76 + key; vp[0] = (bf16_t)(vreg.x & 0xffffu); vp[76] = (bf16_t)(vreg.x >> 16); vp[152] = (bf16_t)(vreg.y & 0xffffu); vp[228] = (bf16_t)(vreg.y >> 16);
              vp[304] = (bf16_t)(vreg.z & 0xffffu); vp[380] = (bf16_t)(vreg.z >> 16); vp[456] = (bf16_t)(vreg.w & 0xffffu); vp[532] = (bf16_t)(vreg.w >> 16); }
            LBAR();
            if (j == 0) nxt = sItem[1];
            if (j + 1 < ntile) { const int jn = j + 1; const int rb = jn < nloc ? b * 2048 + lo + 64 * jn : 16384 + b * 256 + 64 * (jn - nloc);
                const bf16_t* kp = AKV + (size_t)(rb + key) * 256 + g * 64 + seg * 8; kreg = *(const u32x4*)kp; vreg = *(const u32x4*)(kp + 128); }
            else if (nxt < 1024) { ATT_FIRST(nxt, Qn[0], Qn[1]); }
            const int kt0 = lo + 64 * j, qw0 = q0 + 16 * w;
            if (j < nloc && (kt0 + 63 < qw0 - 128 || kt0 > qw0 + 15 + 128)) continue;
            f32x4 s[4];
#pragma unroll
            for (int mb = 0; mb < 4; ++mb) { s[mb] = (f32x4){0.f, 0.f, 0.f, 0.f};
#pragma unroll
                for (int ks = 0; ks < 2; ++ks) s[mb] = MFMA16(*(const bf16x8*)(bK + (16 * mb + r16) * 72 + 32 * ks + 8 * q), Qb[ks], s[mb]); }
            if (j < nloc && (kt0 < qw0 + 15 - 128 || kt0 + 63 > qw0 + 128)) { const int kp0 = lo + 64 * j + 4 * q;
#pragma unroll
                for (int mb = 0; mb < 4; ++mb)
#pragma unroll
                    for (int i = 0; i < 4; ++i) { const int d = qpos - (kp0 + 16 * mb + i); if (d > 128 || d < -128) s[mb][i] = -1e30f; } }
            float tmax = -1e30f;
#pragma unroll
            for (int mb = 0; mb < 4; ++mb)
#pragma unroll
                for (int i = 0; i < 4; ++i) tmax = fmaxf(tmax, s[mb][i]);
            tmax = fmaxf(tmax, __shfl_xor(tmax, 16)); tmax = fmaxf(tmax, __shfl_xor(tmax, 32));
            const float mnew = fmaxf(m, tmax), alpha = __builtin_amdgcn_exp2f(m - mnew); m = mnew; float ls = 0.f;
#pragma unroll
            for (int mb = 0; mb < 4; ++mb)
#pragma unroll
                for (int i = 0; i < 4; ++i) { const float pv = __builtin_amdgcn_exp2f(s[mb][i] - mnew); s[mb][i] = pv; ls += pv; }
            l = l * alpha + ls;
#pragma unroll
            for (int mb = 0; mb < 4; ++mb) O[mb] = O[mb] * alpha;
            bf16x8 pb[2]; pb[0] = pack8(s[0], s[1]); pb[1] = pack8(s[2], s[3]);
#pragma unroll
            for (int mb = 0; mb < 4; ++mb)
#pragma unroll
                for (int ks = 0; ks < 2; ++ks) { const bf16_t* vp = bV + (16 * mb + r16) * 76 + 32 * ks + 4 * q; const u32x2 a = *(const u32x2*)vp, c2 = *(const u32x2*)(vp + 16); u32x4 av; av.x = a.x; av.y = a.y; av.z = c2.x; av.w = c2.y;
                    O[mb] = MFMA16(__builtin_bit_cast(bf16x8, av), pb[ks], O[mb]); }
        }
        l += __shfl_xor(l, 16); l += __shfl_xor(l, 32); const float inv = 1.0f / l;
#pragma unroll
        for (int mb = 0; mb < 4; ++mb) { u32x2 wv; wv.x = pk2(O[mb][0] * inv, O[mb][1] * inv); wv.y = pk2(O[mb][2] * inv, O[mb][3] * inv); *(u32x2*)(qrow + 16 * mb + 4 * q) = wv; }
        LBAR();
        if (nxt >= 1024) break;
        item = nxt; Qb[0] = Qn[0]; Qb[1] = Qn[1];
    }
#undef ATT_FIRST
}

DI void combine_yd(const Params& P) {
    const bf16_t* OF = (const bf16_t*)(P.ws + WS_OF); const bf16_t* OB = (const bf16_t*)(P.ws + WS_OB); const bf16_t* DZ = (const bf16_t*)(P.ws + WS_DZ); bf16_t* YD = (bf16_t*)(P.ws + WS_YD); const float* g = P.in[14];
    const int stride = gridDim.x * NT; int task = blockIdx.x * NT + threadIdx.x;
    u32x4 ar[2], cr[2], zr[2];
    if (task < 524288) { const size_t off = (size_t)task * 16; ar[0] = *(const u32x4*)(OF + off); ar[1] = *(const u32x4*)(OF + off + 8); cr[0] = *(const u32x4*)(OB + off); cr[1] = *(const u32x4*)(OB + off + 8); zr[0] = *(const u32x4*)(DZ + off); zr[1] = *(const u32x4*)(DZ + off + 8); }
    for (; task < 524288; task += stride) {
        const size_t off = (size_t)task * 16; const int seg = task & 3; float v[16]; float ss = 0.f; u32x4 an[2], cn[2], zn[2];
#pragma unroll
        for (int j = 0; j < 2; ++j) { an[j] = ar[j]; cn[j] = cr[j]; zn[j] = zr[j]; }
        if (task + stride < 524288) { const size_t o2 = (size_t)(task + stride) * 16;
            an[0] = *(const u32x4*)(OF + o2); an[1] = *(const u32x4*)(OF + o2 + 8); cn[0] = *(const u32x4*)(OB + o2); cn[1] = *(const u32x4*)(OB + o2 + 8); zn[0] = *(const u32x4*)(DZ + o2); zn[1] = *(const u32x4*)(DZ + o2 + 8); }
#pragma unroll
        for (int j = 0; j < 2; ++j) { const u32x4 a = ar[j], c = cr[j];
            v[j * 8 + 0] = lo16(a.x) + lo16(c.x); v[j * 8 + 1] = hi16(a.x) + hi16(c.x); v[j * 8 + 2] = lo16(a.y) + lo16(c.y); v[j * 8 + 3] = hi16(a.y) + hi16(c.y);
            v[j * 8 + 4] = lo16(a.z) + lo16(c.z); v[j * 8 + 5] = hi16(a.z) + hi16(c.z); v[j * 8 + 6] = lo16(a.w) + lo16(c.w); v[j * 8 + 7] = hi16(a.w) + hi16(c.w); }
#pragma unroll
        for (int d = 0; d < 16; ++d) ss += v[d] * v[d];
        ss += __shfl_xor(ss, 1); ss += __shfl_xor(ss, 2);
        const float rs = rsqrtf(ss * (1.0f / 64.0f) + 1e-6f);
#pragma unroll
        for (int j = 0; j < 2; ++j) { const u32x4 z = zr[j]; float y[8];
            y[0] = silu(lo16(z.x)); y[1] = silu(hi16(z.x)); y[2] = silu(lo16(z.y)); y[3] = silu(hi16(z.y)); y[4] = silu(lo16(z.z)); y[5] = silu(hi16(z.z)); y[6] = silu(lo16(z.w)); y[7] = silu(hi16(z.w));
#pragma unroll
            for (int e = 0; e < 8; ++e) y[e] *= v[j * 8 + e] * rs * g[seg * 16 + j * 8 + e];
            u32x4 wv; wv.x = pk2(y[0], y[1]); wv.y = pk2(y[2], y[3]); wv.z = pk2(y[4], y[5]); wv.w = pk2(y[6], y[7]); *(u32x4*)(YD + off + j * 8) = wv; }
#pragma unroll
        for (int j = 0; j < 2; ++j) { ar[j] = an[j]; cr[j] = cn[j]; zr[j] = zn[j]; }
    }
}


DI void dadb_stage(const Params& P, unsigned char* smem) {
    const bf16_t* B = (const bf16_t*)(P.ws + WS_WIN) + (size_t)4864 * 1024;
#pragma unroll
    for (int i = 0; i < 8; ++i) { const int p = threadIdx.x + 512 * i, row = p >> 7, c8 = p & 127; *(u32x4*)((bf16_t*)smem + row * 1032 + c8 * 8) = *(const u32x4*)(B + (size_t)row * 1024 + c8 * 8); }
}
DI void dadb_task(const Params& P, int task, int lane, const unsigned char* smem) {
    const int r16 = lane & 15, q = lane >> 4; const bf16_t* A = (const bf16_t*)(P.ws + WS_H) + (size_t)(task * 16 + r16) * 1024 + 8 * q; const bf16_t* B = (const bf16_t*)smem + r16 * 1032 + 8 * q;
    f32x4 acc0 = (f32x4){0.f, 0.f, 0.f, 0.f}, acc1 = acc0; bf16x8 a[32];
#pragma unroll
    for (int ks = 0; ks < 32; ++ks) a[ks] = *(const bf16x8*)(A + 32 * ks);
    __builtin_amdgcn_sched_barrier(0);
#pragma unroll
    for (int ks = 0; ks < 32; ++ks) { acc0 = MFMA16(a[ks], *(const bf16x8*)(B + 32 * ks), acc0); acc1 = MFMA16(a[ks], *(const bf16x8*)(B + 16 * 1032 + 32 * ks), acc1); }
    float* AB = (float*)(P.ws + WS_AB) + (size_t)(task * 16 + 4 * q) * 32 + r16;
#pragma unroll
    for (int i = 0; i < 4; ++i) { AB[i * 32] = acc0[i]; AB[i * 32 + 16] = acc1[i]; }
}

#define XB_TMO      128
#define XB_XCNT(j)  (256  + 64 * (j))
#define XB_XSUB(j)  (1280 + 64 * (j))
#define XB_XGEN(j)  (2304 + 64 * (j))
#define XB_TOP      3328
#define XB_TOPGEN   3392
#define XCD_BAR_WORDS 3456
#define XB_SPIN_CAP (1u << 18)
#define LASB __attribute__((address_space(3)))
DI unsigned xb_ld(unsigned* p)              { return __hip_atomic_load(p, __ATOMIC_RELAXED, __HIP_MEMORY_SCOPE_AGENT); }
DI unsigned xb_add(unsigned* p, unsigned v) { return __hip_atomic_fetch_add(p, v, __ATOMIC_RELAXED, __HIP_MEMORY_SCOPE_AGENT); }
DI unsigned xb_xcc_id() { return (unsigned)__builtin_amdgcn_s_getreg((3 << 11) | 20) & 0xFu; }
#define XB_SPIN(cond, bar) do { unsigned _sp = 0; while (cond) { __builtin_amdgcn_s_sleep(1); \
    if ((++_sp & 255u) == 0u) { if (xb_ld(&(bar)[XB_TMO])) break; if (_sp > XB_SPIN_CAP) { atomicAdd(&(bar)[XB_TMO], 1u); break; } } } } while (0)
struct XcdBarrier { unsigned* bar; unsigned x; volatile LASB unsigned* st; };
DI XcdBarrier xcd_barrier_post(unsigned* bar, volatile LASB unsigned* st) {
    XcdBarrier b; b.bar = bar; b.x = xb_xcc_id(); b.st = st;
    if (threadIdx.x == 0) (void)xb_add(&bar[XB_XCNT(b.x)], 1u);
    return b;
}
DI void xcd_barrier_complete(unsigned* bar, unsigned x, unsigned& nloc, unsigned& nx) {
    const unsigned G = gridDim.x * gridDim.y * gridDim.z;
    unsigned sum, cnt, mine, sp = 0u;
    for (;;) {
        sum = 0u; cnt = 0u; mine = 0u;
#pragma unroll
        for (unsigned j = 0; j < 16; ++j) { const unsigned c = xb_ld(&bar[XB_XCNT(j)]); sum += c; cnt += (c > 0u) ? 1u : 0u; mine = (j == x) ? c : mine; }
        if (sum == G) break;
        __builtin_amdgcn_s_sleep(1);
        if ((++sp & 255u) == 0u) { if (xb_ld(&bar[XB_TMO])) break; if (sp > XB_SPIN_CAP) { atomicAdd(&bar[XB_TMO], 1u); break; } }
    }
    nloc = mine > 0u ? mine : 1u; nx = cnt > 0u ? cnt : 1u;
}
DI void xcd_barrier(const XcdBarrier& b) {
    asm volatile("s_waitcnt vmcnt(0)" ::: "memory");
    __syncthreads();
    if (threadIdx.x == 0) {
        unsigned* bar = b.bar;
        __builtin_amdgcn_s_waitcnt(0);
        unsigned nloc = b.st[0], nx = b.st[1];
        if (nloc == 0u) { xcd_barrier_complete(bar, b.x, nloc, nx); b.st[0] = nloc; b.st[1] = nx; }
        const unsigned old = xb_add(&bar[XB_XSUB(b.x)], 1u);
        const unsigned gen = old / nloc;
        if (old + 1u == (gen + 1u) * nloc) {
            __builtin_amdgcn_fence(__ATOMIC_RELEASE, "agent");
            asm volatile("s_waitcnt vmcnt(0)" ::: "memory");
            const unsigned og = xb_add(&bar[XB_TOP], 1u);
            const unsigned tg = og / nx;
            if (og + 1u == (tg + 1u) * nx) xb_add(&bar[XB_TOPGEN], 1u);
            else XB_SPIN(xb_ld(&bar[XB_TOPGEN]) == tg, bar);
            __builtin_amdgcn_fence(__ATOMIC_ACQUIRE, "agent");
            xb_add(&bar[XB_XGEN(b.x)], 1u);
            asm volatile("s_waitcnt vmcnt(0)" ::: "memory");
        } else {
            XB_SPIN(xb_ld(&bar[XB_XGEN(b.x)]) == gen, bar);
            __builtin_amdgcn_fence(__ATOMIC_ACQUIRE, "agent");
            asm volatile("s_waitcnt vmcnt(0)" ::: "memory");
        }
    }
    __syncthreads();
}

__global__ void __launch_bounds__(NT) fwd(Params P) {
    extern __shared__ __attribute__((aligned(16))) unsigned char lds[];
    cg::grid_group grid = cg::this_grid();
    const int tid = threadIdx.x, bid = blockIdx.x, G = gridDim.x;
    unsigned char* ws = P.ws;
    volatile int* sItem = (volatile int*)(lds + 131072);
    if (tid < 8) ((volatile LASB unsigned*)(lds + 131072 + 16))[tid] = 0u;
    __syncthreads();
    XcdBarrier xbar = xcd_barrier_post((unsigned*)(ws + 4096), (volatile LASB unsigned*)(lds + 131072 + 16));
    if (P.ws == nullptr) grid.sync();
#define GRID_SYNC() xcd_barrier(xbar)
    pg8::EpiP ep; ep.AQ = (bf16_t*)(ws + WS_AQ); ep.AKV = (bf16_t*)(ws + WS_AKV); ep.DQKV = (bf16_t*)(ws + WS_DQKV); ep.DZ = (bf16_t*)(ws + WS_DZ); ep.GATES = (bf16_t*)P.out; ep.Y = (bf16_t*)(ws + WS_Y);
    ep.AB = (float*)(ws + WS_AB); ep.x = P.in[0]; ep.mod = (const float*)(ws + WS_MOD); ep.out = P.out; ep.ACT = (bf16_t*)(ws + WS_ACT); ep.g2 = P.in[18]; ep.H2 = (bf16_t*)(ws + WS_H2); ep.rowsq = (float*)(ws + WS_ROWSQ); ep.bias = (const float*)(ws + WS_BIAS);
    PG8_LAS unsigned char* glds = (PG8_LAS unsigned char*)lds;

#ifdef PROBE_SYNC
    for (int i = 0; i < PROBE_SYNC; ++i) GRID_SYNC();
#endif
    { float* tile = (float*)lds;
#ifndef NO_P0
      for (int it = bid; it < 768; it += G) mod_item(P, it, tile);
#define DEC_WIN(t) dec_win(P, (t))
      __syncthreads(); CONV_TILES(bid, G, 624, DEC_WIN, tile, NO_HOOK);
      const int gt = bid * NT + tid; if (gt < 1024) { const int pos = gt >> 4, f = gt & 15; const float ang = (float)pos * powf(10000.0f, -(float)f / 16.0f); float* TAB = (float*)(ws + WS_TAB); TAB[2 * gt] = cosf(ang); TAB[2 * gt + 1] = sinf(ang); }
#endif
    }
    GRID_SYNC();
#ifndef NO_P1
#ifdef PROBE_P1
    for (int rep = 0; rep < PROBE_P1; ++rep)
#endif
    modnorm_rows(P.in[0], P.in[2], 18432, P.in[6], (const float*)(ws + WS_MOD), 0, 1024, (bf16_t*)(ws + WS_H));
#endif
    GRID_SYNC();
#ifndef NO_P2
#ifdef PROBE_G1
    for (int rep = 0; rep < PROBE_G1; ++rep)
#endif
    { pg8::Gemm g{(const bf16_t*)(ws + WS_H), (const bf16_t*)(ws + WS_WIN), 18432, 4864, 1024}; pg8::SchedIn S{G, bid}; pg8::Epi<0> E{ep}; pg8::gemm_phase<pg8::Epi<0>, pg8::SchedIn, GEMM_ALIGN, GEMM_SP2>(glds, g, S, E); }
    { dadb_stage(P, lds); __syncthreads();
    for (int task = (tid >> 6) * G + bid; task < 1152; task += G * 8) dadb_task(P, task, tid & 63, lds); }
#endif
    GRID_SYNC();
#ifndef NO_P4A
#ifdef PROBE_PREP
    for (int rep = 0; rep < PROBE_PREP; ++rep)
#endif
    prep_phase(P, lds);
#endif
#ifndef NO_P4B
    qk_normrope(P);
#endif
    GRID_SYNC();
#ifndef NO_P5A
#ifdef PROBE_SCAN
    for (int rep = 0; rep < PROBE_SCAN; ++rep)
#endif
    if (bid < 128) scan_block(P, bid, lds);
#endif
#ifndef NO_P5B
    attn_phase(P, lds, (unsigned*)(ws + WS_CTL), sItem);
#endif
    { float* tile = (float*)lds;
#define DEC_REST(t) dec_rest(P, (t))
      __syncthreads(); CONV_TILES(bid, G, 1280, DEC_REST, tile, BIAS_HOOK); }
    GRID_SYNC();
#ifndef NO_P6
#ifdef PROBE_EW
    for (int rep = 0; rep < PROBE_EW; ++rep) {
#else
    {
#endif
    combine_yd(P);
    }
#endif
    GRID_SYNC();
#ifndef NO_P7
#ifdef PROBE_G23
    for (int rep = 0; rep < PROBE_G23; ++rep)
#endif
    { pg8::Gemm g{(const bf16_t*)(ws + WS_AQ), (const bf16_t*)(ws + WS_WBR), 16384, 1024, 512, 16, 8, (size_t)16 * MiB - 1024, (size_t)1024 * 512 * 2 - 1024}; pg8::SchedStd S{4, 256, G, bid}; pg8::Epi<1> E{ep}; pg8::gemm_phase<pg8::Epi<1>, pg8::SchedStd, GEMM_ALIGN, GEMM_SP2>(glds, g, S, E); }
#endif
    GRID_SYNC();
#ifndef NO_P8
#ifdef PROBE_G23
    for (int rep = 0; rep < PROBE_G23; ++rep)
#endif
    { pg8::Gemm g{(const bf16_t*)(ws + WS_Y), (const bf16_t*)(ws + WS_WOUT), 16384, 1024, 1024}; pg8::SchedStd S{4, 256, G, bid}; pg8::Epi<2> E{ep}; pg8::gemm_phase<pg8::Epi<2>, pg8::SchedStd, GEMM_ALIGN, GEMM_SP2>(glds, g, S, E); }
#endif
    GRID_SYNC();
#ifndef NO_P10
#ifdef PROBE_G4
    for (int rep = 0; rep < PROBE_G4; ++rep)
#endif
    { pg8::Gemm g{(const bf16_t*)(ws + WS_H2), (const bf16_t*)(ws + WS_WM1), 16384, 4096, 1024}; pg8::SchedStd S{16, 1024, G, bid}; pg8::Epi<3> E{ep}; pg8::gemm_phase<pg8::Epi<3>, pg8::SchedStd, GEMM_ALIGN, GEMM_SP2>(glds, g, S, E); }
#endif
    GRID_SYNC();
#ifndef NO_P11
    { pg8::Gemm g{(const bf16_t*)(ws + WS_ACT), (const bf16_t*)(ws + WS_WM2), 16384, 1024, 4096}; pg8::SchedStd S{4, 256, G, bid}; pg8::Epi<4> E{ep}; pg8::gemm_phase<pg8::Epi<4>, pg8::SchedStd, GEMM_ALIGN, GEMM_SP2>(glds, g, S, E); }
#endif
}
}

extern "C" void kernel_launch(void* const* d_in, const int* in_sizes, int n_in, void* d_out, int out_size, void* d_ws, size_t ws_size, hipStream_t stream) {
    static int grid = 0;
    if (grid == 0) {
        if (n_in != 21 || ws_size < mk::WS_END) { fprintf(stderr, "kernel_launch: unexpected inputs (n_in %d, ws %zu)\n", n_in, ws_size); grid = -1; return; }
        int dev = 0, cus = 0, per_cu = 0;
        hipGetDevice(&dev); hipDeviceGetAttribute(&cus, hipDeviceAttributeMultiprocessorCount, dev);
        if (hipFuncSetAttribute((const void*)mk::fwd, hipFuncAttributeMaxDynamicSharedMemorySize, mk::LDS_BYTES) != hipSuccess) { fprintf(stderr, "kernel_launch: hipFuncSetAttribute failed\n"); grid = -1; return; }
        if (hipOccupancyMaxActiveBlocksPerMultiprocessor(&per_cu, (const void*)mk::fwd, mk::NT, mk::LDS_BYTES) != hipSuccess || per_cu < 1) { fprintf(stderr, "kernel_launch: occupancy query says %d\n", per_cu); per_cu = 1; }
        (void)hipGetLastError();
        grid = cus * 1;
        if (grid % 8 != 0 || grid < 64) { fprintf(stderr, "kernel_launch: unexpected CU count %d\n", cus); }
    }
    if (grid < 0) return;
    hipMemsetAsync((char*)d_ws + mk::WS_CTL, 0, 512 * 1024, stream);
    mk::Params p{};
    for (int i = 0; i < 21; ++i) p.in[i] = (const float*)d_in[i];
    p.out = (float*)d_out; p.ws = (unsigned char*)d_ws;
    void* args[] = {&p};
    hipError_t e = hipLaunchCooperativeKernel((const void*)mk::fwd, dim3(grid), dim3(mk::NT), args, mk::LDS_BYTES, stream);
    if (e != hipSuccess) fprintf(stderr, "cooperative launch failed: %s (grid %d)\n", hipGetErrorString(e), grid);
}
```

```cpp
#include <hip/hip_runtime.h>
#include <hip/hip_cooperative_groups.h>
#include <cstdio>
#include <cstdint>
namespace cg = cooperative_groups;

namespace pg8 {
#define PG8_LAS __attribute__((address_space(3)))
typedef unsigned short bf16_t;
typedef short bf16x8 __attribute__((ext_vector_type(8)));
typedef float f32x4 __attribute__((ext_vector_type(4)));
typedef unsigned u32x4 __attribute__((ext_vector_type(4)));
constexpr int BM = 256, BK = 64, HALF = 128, HTB = HALF * BK * 2  , STAGE_BYTES = 8 * HTB, NXCD = 8, WGM = 8;

__host__ __device__ __forceinline__ int lds_byte(int r, int c) { const int st = (r >> 4) * 2 + (c >> 5), rr = r & 15, cc = c & 31, ob = rr * 64 + cc * 2; return st * 1024 + (ob ^ (((ob >> 9) & 1) << 5)); }
__host__ __device__ __forceinline__ void stage_rc(int b, int& R, int& C) { const int st = b / 1024, sb = b % 1024, swz = sb ^ (((sb >> 9) & 1) << 5); R = (st >> 1) * 16 + swz / 64; C = (st & 1) * 32 + (swz % 64) / 2; }
__host__ __device__ __forceinline__ int perm32(int rho) { const int n = rho >> 4, i = rho & 15; return 8 * (i >> 2) + 4 * n + (i & 3); }

struct Unit { int pm, pn; };
struct Gemm { const bf16_t* A; const bf16_t* Bt; int M, N, K; int nt = 0, jt = 0; size_t ja = 0, jb = 0; };


typedef unsigned u32x2 __attribute__((ext_vector_type(2)));
typedef short s16x4 __attribute__((ext_vector_type(4)));
__device__ __forceinline__ unsigned pk2(float a, float b) { typedef __bf16 bv2 __attribute__((ext_vector_type(2))); bv2 v; v[0] = (__bf16)a; v[1] = (__bf16)b; return __builtin_bit_cast(unsigned, v); }
__device__ __forceinline__ float lo16(unsigned u) { return __uint_as_float(u << 16); }
__device__ __forceinline__ float hi16(unsigned u) { return __uint_as_float(u & 0xffff0000u); }
__device__ __forceinline__ float bf2f(bf16_t v) { return __uint_as_float(((unsigned)v) << 16); }

__device__ __forceinline__ void map_static(int L, int nwg, int nN, int& pm, int& pn) {
    const int q = nwg / NXCD, xcd = L % NXCD, off = L / NXCD, wgid = xcd * q + off;
    const int nig = WGM * nN, gid = wgid / nig; pm = gid * WGM + ((wgid % nig) % WGM); pn = (wgid % nig) / WGM;
}
struct SchedStd {
    int nN, nwg, G, c;
    __device__ __forceinline__ bool next(int i, Unit& u) const { const long L = (long)i * G + c; if (L >= nwg) return false; map_static((int)L, nwg, nN, u.pm, u.pn); return true; }
    __device__ __forceinline__ void a_ready(const Unit&) const {}
    __device__ __forceinline__ void done(const Unit&) const {}
};
struct SchedIn {
    int G, c;
    __device__ __forceinline__ bool next(int i, Unit& u) const {
        const long L = (long)i * G + c; if (L >= 1256) return false;
        if (L < 1216) map_static((int)L, 1216, 19, u.pm, u.pn);
        else { const int Lc = (int)L - 1216, t = Lc >> 3; u.pm = 64 + (Lc & 7); u.pn = t == 0 ? 2 : t + 4; }
        return true;
    }
    __device__ __forceinline__ void a_ready(const Unit&) const {}
    __device__ __forceinline__ void done(const Unit&) const {}
};
struct SchedBr {
    int G, c;
    __device__ __forceinline__ bool next(int i, Unit& u) const {
        const long L = (long)(i >> 1) * G + c; if (L >= 256) return false; const int br = i & 1; int pm, pn; map_static((int)L, 256, 4, pm, pn);
        u.pm = pm + 64 * br; u.pn = pn + 4 * br; return true;
    }
    __device__ __forceinline__ void a_ready(const Unit&) const {}
    __device__ __forceinline__ void done(const Unit&) const {}
};

struct EpiP { bf16_t* AQ; bf16_t* AKV; bf16_t* DQKV; bf16_t* DZ; bf16_t* GATES; bf16_t* Y; float* AB; const float* x; const float* mod; float* out; bf16_t* ACT; const float* g2; bf16_t* H2; float* rowsq; const float* bias; };
template <int MODE> struct Epi {
    static constexpr bool PERM = true, AFTER_DRAIN = false, HAS_MID = (MODE == 1);
    EpiP p;
    __device__ __forceinline__ void operator()(const f32x4 (&acc)[2][2][4][2], const Unit& u, int wr, int wc, int fr, int fq) const {
        if (MODE == 0) {
            const int pn = u.pn; const int row0 = u.pm * BM + wr * 64 + fr;
            if (pn >= 11) {
                const int colg = (pn - 11) * 128 + wc * 32 + 8 * fq;
#pragma unroll
                for (int ai = 0; ai < 2; ++ai)
#pragma unroll
                    for (int m = 0; m < 4; ++m) { bf16_t* rp = p.GATES + (size_t)(row0 + ai * HALF + m * 16) * 2048 + colg; f32x4 rr[2], sd[2];
#pragma unroll
                        for (int n = 0; n < 2; ++n)
#pragma unroll
                            for (int j = 0; j < 4; ++j) { const float ga = fminf(fmaxf(acc[ai][0][m][n][j], -30.f), 30.f), gd = fminf(fmaxf(acc[ai][1][m][n][j], -30.f), 30.f);
                                const float ea = 1.0f + __expf(-ga), ed = 1.0f + __expf(-gd), ia = __builtin_amdgcn_rcpf(ea); rr[n][j] = ed * ia; sd[n][j] = __builtin_amdgcn_rcpf(ed); }
                        u32x4 w; w.x = pk2(rr[0][0], rr[0][1]); w.y = pk2(rr[0][2], rr[0][3]); w.z = pk2(rr[1][0], rr[1][1]); w.w = pk2(rr[1][2], rr[1][3]); *(u32x4*)rp = w;
                        w.x = pk2(sd[0][0], sd[0][1]); w.y = pk2(sd[0][2], sd[0][3]); w.z = pk2(sd[1][0], sd[1][1]); w.w = pk2(sd[1][2], sd[1][3]); *(u32x4*)(rp + 1024) = w; }
                return;
            }
            bf16_t* base; int ld, cofs;
            if (pn < 2) { base = p.AQ; ld = 512; cofs = 0; } else if (pn == 2) { base = p.AKV; ld = 256; cofs = 512; } else if (pn < 9) { base = p.DQKV; ld = 1536; cofs = 768; }
            else { base = p.DZ; ld = 512; cofs = 2304; }
            const int colt = pn * BM - cofs + wc * 32 + 8 * fq;
#pragma unroll
            for (int ai = 0; ai < 2; ++ai)
#pragma unroll
                for (int m = 0; m < 4; ++m) { bf16_t* rp = base + (size_t)(row0 + ai * HALF + m * 16) * ld + colt;
#pragma unroll
                    for (int bj = 0; bj < 2; ++bj) { const f32x4 v0 = acc[ai][bj][m][0], v1 = acc[ai][bj][m][1];
                        u32x4 w; w.x = pk2(v0[0], v0[1]); w.y = pk2(v0[2], v0[3]); w.z = pk2(v1[0], v1[1]); w.w = pk2(v1[2], v1[3]); *(u32x4*)(rp + bj * HALF) = w; } }
        } else if (MODE == 1) {
            const int row0 = u.pm * BM + wr * 64 + fr, col0 = u.pn * BM + wc * 32 + 8 * fq;
#pragma unroll
            for (int ai = 0; ai < 2; ++ai) { u32x4 g[4][2];
#pragma unroll
                for (int m = 0; m < 4; ++m)
#pragma unroll
                    for (int bj = 0; bj < 2; ++bj) g[m][bj] = *(const u32x4*)(p.GATES + (size_t)(row0 + ai * HALF + m * 16) * 2048 + 1024 + col0 + bj * HALF);
#pragma unroll
                for (int m = 0; m < 4; ++m) { bf16_t* yp = p.Y + (size_t)(row0 + ai * HALF + m * 16) * 1024 + col0;
#pragma unroll
                    for (int bj = 0; bj < 2; ++bj) { const f32x4 a0 = acc[ai][bj][m][0], a1 = acc[ai][bj][m][1]; const u32x4 gg = g[m][bj];
                        u32x4 w; w.x = pk2(lo16(gg.x) * a0[0], hi16(gg.x) * a0[1]); w.y = pk2(lo16(gg.y) * a0[2], hi16(gg.y) * a0[3]); w.z = pk2(lo16(gg.z) * a1[0], hi16(gg.z) * a1[1]); w.w = pk2(lo16(gg.w) * a1[2], hi16(gg.w) * a1[3]);
                        *(u32x4*)(yp + bj * HALF) = w; } } }
        } else if (MODE == 2) {
            const int row0 = u.pm * BM + wr * 64 + fr, col0 = u.pn * BM + wc * 32 + 8 * fq; const float* mb = p.mod + (size_t)(u.pm >> 3) * 6144 + col0;
            f32x4 gv[2][2], hv[2][2];
#pragma unroll
            for (int bj = 0; bj < 2; ++bj)
#pragma unroll
                for (int n = 0; n < 2; ++n) { gv[bj][n] = *(const f32x4*)(mb + 2048 + bj * HALF + n * 4); hv[bj][n] = *(const f32x4*)(p.g2 + col0 + bj * HALF + n * 4) * (*(const f32x4*)(mb + 4096 + bj * HALF + n * 4) + 1.0f); }
#pragma unroll
            for (int ai = 0; ai < 2; ++ai)
#pragma unroll
                for (int mh = 0; mh < 2; ++mh) { f32x4 xb[2][2][2];
#pragma unroll
                    for (int mm = 0; mm < 2; ++mm)
#pragma unroll
                        for (int bj = 0; bj < 2; ++bj)
#pragma unroll
                            for (int n = 0; n < 2; ++n) xb[mm][bj][n] = *(const f32x4*)(p.x + (size_t)(row0 + ai * HALF + (2 * mh + mm) * 16) * 1024 + col0 + bj * HALF + n * 4);
#pragma unroll
                    for (int mm = 0; mm < 2; ++mm) { const int m = 2 * mh + mm; const int row = row0 + ai * HALF + m * 16; const size_t off = (size_t)row * 1024 + col0; float ss = 0.f;
#pragma unroll
                        for (int bj = 0; bj < 2; ++bj) { f32x4 a2[2];
#pragma unroll
                            for (int n = 0; n < 2; ++n) { const f32x4 x1 = xb[mm][bj][n] + gv[bj][n] * acc[ai][bj][m][n];
                                *(f32x4*)(p.out + off + bj * HALF + n * 4) = x1; ss += x1[0] * x1[0] + x1[1] * x1[1] + x1[2] * x1[2] + x1[3] * x1[3]; a2[n] = x1 * hv[bj][n]; }
                            u32x4 w; w.x = pk2(a2[0][0], a2[0][1]); w.y = pk2(a2[0][2], a2[0][3]); w.z = pk2(a2[1][0], a2[1][1]); w.w = pk2(a2[1][2], a2[1][3]); *(u32x4*)(p.H2 + off + bj * HALF) = w; }
                        ss += __shfl_xor(ss, 16); ss += __shfl_xor(ss, 32); if (fq == 0) atomicAdd(p.rowsq + row, ss); } }
        } else if (MODE == 4) {
            const int row0 = u.pm * BM + wr * 64 + fr, col0 = u.pn * BM + wc * 32 + 8 * fq; const float* gt = p.mod + (size_t)(u.pm >> 3) * 6144 + 5120 + col0;
            f32x4 gv[2][2];
#pragma unroll
            for (int bj = 0; bj < 2; ++bj)
#pragma unroll
                for (int n = 0; n < 2; ++n) gv[bj][n] = *(const f32x4*)(gt + bj * HALF + n * 4);
#pragma unroll
            for (int ai = 0; ai < 2; ++ai) { f32x4 ob[4][2][2];
#pragma unroll
                for (int m = 0; m < 4; ++m)
#pragma unroll
                    for (int bj = 0; bj < 2; ++bj)
#pragma unroll
                        for (int n = 0; n < 2; ++n) ob[m][bj][n] = *(const f32x4*)(p.out + (size_t)(row0 + ai * HALF + m * 16) * 1024 + col0 + bj * HALF + n * 4);
#pragma unroll
                for (int m = 0; m < 4; ++m) { const size_t off = (size_t)(row0 + ai * HALF + m * 16) * 1024 + col0;
#pragma unroll
                    for (int bj = 0; bj < 2; ++bj)
#pragma unroll
                        for (int n = 0; n < 2; ++n) *(f32x4*)(p.out + off + bj * HALF + n * 4) = ob[m][bj][n] + gv[bj][n] * acc[ai][bj][m][n]; } }
        } else {
            const int row0 = u.pm * BM + wr * 64 + fr, col0 = u.pn * BM + wc * 32 + 8 * fq; const float* bp = p.bias + (size_t)(u.pm >> 3) * 4096 + col0;
            f32x4 bv[2][2];
#pragma unroll
            for (int bj = 0; bj < 2; ++bj)
#pragma unroll
                for (int n = 0; n < 2; ++n) bv[bj][n] = *(const f32x4*)(bp + bj * HALF + n * 4);
            float rq[2][4];
#pragma unroll
            for (int ai = 0; ai < 2; ++ai)
#pragma unroll
                for (int m = 0; m < 4; ++m) rq[ai][m] = p.rowsq[row0 + ai * HALF + m * 16];
#pragma unroll
            for (int ai = 0; ai < 2; ++ai)
#pragma unroll
                for (int m = 0; m < 4; ++m) { const int row = row0 + ai * HALF + m * 16; bf16_t* rp = p.ACT + (size_t)row * 4096 + col0; const float rstd = rsqrtf(rq[ai][m] * (1.0f / 1024.0f) + 1e-6f);
#pragma unroll
                    for (int bj = 0; bj < 2; ++bj) { f32x4 v0 = acc[ai][bj][m][0] * rstd + bv[bj][0], v1 = acc[ai][bj][m][1] * rstd + bv[bj][1];
#pragma unroll
                        for (int j = 0; j < 4; ++j) { const float t0 = fmaxf(v0[j], 0.f), t1 = fmaxf(v1[j], 0.f); v0[j] = t0 * t0; v1[j] = t1 * t1; }
                        u32x4 w; w.x = pk2(v0[0], v0[1]); w.y = pk2(v0[2], v0[3]); w.z = pk2(v1[0], v1[1]); w.w = pk2(v1[2], v1[3]); *(u32x4*)(rp + bj * HALF) = w; } }
        }
    }
    __device__ __forceinline__ void mid(f32x4 (&acc)[2][2][4][2], const Unit& u, int wr, int wc, int fr, int fq) const {
        const int row0 = u.pm * BM + wr * 64 + fr, col0 = u.pn * BM + wc * 32 + 8 * fq;
        const bf16_t* gp = p.GATES + (size_t)row0 * 2048 + col0;
#pragma unroll
        for (int ai = 0; ai < 2; ++ai)
#pragma unroll
            for (int m = 0; m < 4; ++m) { asm volatile("" : "+v"(gp));
#pragma unroll
                for (int bj = 0; bj < 2; ++bj) { const u32x4 g = *(const u32x4*)(gp + bj * HALF);
                    acc[ai][bj][m][0][0] *= lo16(g.x); acc[ai][bj][m][0][1] *= hi16(g.x); acc[ai][bj][m][0][2] *= lo16(g.y); acc[ai][bj][m][0][3] *= hi16(g.y);
                    acc[ai][bj][m][1][0] *= lo16(g.z); acc[ai][bj][m][1][1] *= hi16(g.z); acc[ai][bj][m][1][2] *= lo16(g.w); acc[ai][bj][m][1][3] *= hi16(g.w); }
                gp += (m == 3 ? (HALF - 48) : 16) * 2048;
                if (m == 1 || m == 3) asm volatile("" ::: "memory"); }
    }
};

template <class Epi, class Sched, bool ALIGN_EPI = false, bool SP2 = false>
__device__ __forceinline__ void gemm_phase(PG8_LAS unsigned char* lds, const Gemm g, const Sched& S, const Epi& E) {
    int tid_ = threadIdx.x; asm volatile("" : "+v"(tid_)); const int tid = tid_, wid = __builtin_amdgcn_readfirstlane(tid >> 6), lane = tid & 63, wr = wid >> 2, wc = wid & 3, fr = lane & 15, fq = lane >> 4;
    const int K = g.K, nt = g.nt ? g.nt : K / BK;
    unsigned voffA[2], voffB[2];
#pragma unroll
    for (int i = 0; i < 2; ++i) { int R, C; stage_rc(tid * 16 + i * 8192, R, C); const int Rb = Epi::PERM ? ((R & ~31) + perm32(R & 31)) : R;
        voffA[i] = (unsigned)(R * K + C) * 2u; voffB[i] = (unsigned)(Rb * K + C) * 2u; }
    const size_t kstep = (size_t)(BK * 2);
    const size_t hstep = (size_t)HALF * K * 2;
    const size_t tstep = 2 * hstep;
    const unsigned ldsw = (unsigned)wid * 1024u;
    const int aoff = lds_byte(wr * 64 + fr, fq * 8), boff = lds_byte(wc * 32 + fr, fq * 8);
#define PG8_SA(b, h) (((b) * 2 + (h)) * HTB)
#define PG8_SB(b, h) ((4 + (b) * 2 + (h)) * HTB)
#define PG8_STAGE(bufoff, gbase, voff) do { _Pragma("unroll") for (int _i = 0; _i < 2; ++_i) \
        __builtin_amdgcn_global_load_lds((const unsigned*)((const char*)(gbase) + (voff)[_i]), (PG8_LAS unsigned*)(lds + (bufoff) + ldsw + _i * 8192), 16, 0, 0); } while (0)
#define PG8_LDA(dst, b, h) do { _Pragma("unroll") for (int m = 0; m < 4; ++m) _Pragma("unroll") for (int k = 0; k < 2; ++k) dst[m][k] = *(const PG8_LAS bf16x8*)(lds + PG8_SA(b, h) + aoff + m * 2048 + k * 1024); } while (0)
#define PG8_LDB(dst, b, h) do { _Pragma("unroll") for (int n = 0; n < 2; ++n) _Pragma("unroll") for (int k = 0; k < 2; ++k) dst[n][k] = *(const PG8_LAS bf16x8*)(lds + PG8_SB(b, h) + boff + n * 2048 + k * 1024); } while (0)
#define PG8_MMA(ai, bj, At, Bt) do { __builtin_amdgcn_s_setprio(1); _Pragma("unroll") for (int m = 0; m < 4; ++m) _Pragma("unroll") for (int n = 0; n < 2; ++n) _Pragma("unroll") for (int k = 0; k < 2; ++k) \
        acc[ai][bj][m][n] = __builtin_amdgcn_mfma_f32_16x16x32_bf16(Bt[n][k], At[m][k], acc[ai][bj][m][n], 0, 0, 0); __builtin_amdgcn_s_setprio(0); } while (0)
#define PG8_WAIT_V(n) asm volatile("s_waitcnt vmcnt(" #n ")" ::: "memory")
#define PG8_WAIT_L(n) asm volatile("s_waitcnt lgkmcnt(" #n ")" ::: "memory")
#define PG8_BAR __builtin_amdgcn_s_barrier()
#define PG8_SCHED __builtin_amdgcn_sched_barrier(0)
    Unit cur, nxt; int ui = 0;
    if (!S.next(0, cur)) return;
    f32x4 acc[2][2][4][2];
#pragma unroll
    for (int a = 0; a < 2; ++a)
#pragma unroll
        for (int b = 0; b < 2; ++b)
#pragma unroll
            for (int m = 0; m < 4; ++m)
#pragma unroll
                for (int n = 0; n < 2; ++n) acc[a][b][m][n] = (f32x4){0.f, 0.f, 0.f, 0.f};
    bf16x8 At[4][2], B0[2][2], B1[2][2];
    const char* cA = (const char*)g.A + (size_t)cur.pm * tstep; const char* cB = (const char*)g.Bt + (size_t)cur.pn * tstep;
    S.a_ready(cur);
    if constexpr (SP2) {
        PG8_STAGE(PG8_SB(0, 0), cB, voffB); PG8_STAGE(PG8_SB(0, 1), cB + hstep, voffB); PG8_STAGE(PG8_SA(0, 0), cA, voffA); PG8_STAGE(PG8_SA(0, 1), cA + hstep, voffA);
        if (wr == 1) PG8_BAR;
        PG8_WAIT_V(2); PG8_BAR;
        PG8_STAGE(PG8_SB(1, 0), cB + kstep, voffB); PG8_STAGE(PG8_SA(1, 0), cA + kstep, voffA); PG8_STAGE(PG8_SB(1, 1), cB + hstep + kstep, voffB);
        PG8_WAIT_V(6); PG8_BAR;
    } else {
        PG8_STAGE(PG8_SB(0, 0), cB, voffB); PG8_STAGE(PG8_SA(0, 0), cA, voffA); PG8_STAGE(PG8_SB(0, 1), cB + hstep, voffB); PG8_STAGE(PG8_SA(0, 1), cA + hstep, voffA);
        if (wr == 1) PG8_BAR;
        PG8_WAIT_V(4); PG8_BAR;
        PG8_STAGE(PG8_SB(1, 0), cB + kstep, voffB); PG8_STAGE(PG8_SA(1, 0), cA + kstep, voffA); PG8_STAGE(PG8_SB(1, 1), cB + hstep + kstep, voffB);
        PG8_WAIT_V(6); PG8_BAR;
    }
    for (;;) {
        const bool has_next = S.next(ui + 1, nxt);
        const char* nA = has_next ? (const char*)g.A + (size_t)nxt.pm * tstep : cA; const char* nB = has_next ? (const char*)g.Bt + (size_t)nxt.pn * tstep : cB;
        for (int t = 0; t < nt; t += 2) {
            const bool last = (t == nt - 2);
            const size_t j1a = (g.jt && t + 1 >= g.jt) ? g.ja : 0, j2a = (g.jt && t + 2 >= g.jt) ? g.ja : 0, j2b = (g.jt && t + 2 >= g.jt) ? g.jb : 0;
            const char* a1 = cA + (size_t)(t + 1) * kstep + j1a;
            const char* a2 = last ? nA : cA + (size_t)(t + 2) * kstep + j2a; const char* b2 = last ? nB : cB + (size_t)(t + 2) * kstep + j2b;
            if constexpr (Epi::HAS_MID) { if (g.jt && t == g.jt) E.mid(acc, cur, wr, wc, fr, fq); }
            const char* a3 = a2 + kstep; const char* b3 = b2 + kstep;
            if (last && has_next) S.a_ready(nxt);
            if constexpr (SP2) {
            PG8_LDB(B0, 0, 0); PG8_LDB(B1, 0, 1); PG8_SCHED; PG8_LDA(At, 0, 0); PG8_STAGE(PG8_SA(1, 1), a1 + hstep, voffA);
            PG8_WAIT_V(8); PG8_WAIT_L(0); PG8_BAR; PG8_MMA(0, 0, At, B0); PG8_MMA(0, 1, At, B1); PG8_BAR; PG8_SCHED;
            PG8_LDA(At, 0, 1); PG8_STAGE(PG8_SB(0, 0), b2, voffB); PG8_STAGE(PG8_SB(0, 1), b2 + hstep, voffB); PG8_STAGE(PG8_SA(0, 0), a2, voffA);
            PG8_WAIT_V(8); PG8_WAIT_L(0); PG8_BAR; PG8_MMA(1, 0, At, B0); PG8_MMA(1, 1, At, B1); PG8_BAR; PG8_SCHED;
            PG8_LDB(B0, 1, 0); PG8_LDB(B1, 1, 1); PG8_SCHED; PG8_LDA(At, 1, 0); PG8_STAGE(PG8_SA(0, 1), a2 + hstep, voffA);
            PG8_WAIT_V(8); PG8_WAIT_L(0); PG8_BAR; PG8_MMA(0, 0, At, B0); PG8_MMA(0, 1, At, B1); PG8_BAR; PG8_SCHED;
            PG8_LDA(At, 1, 1); PG8_STAGE(PG8_SB(1, 0), b3, voffB); PG8_STAGE(PG8_SB(1, 1), b3 + hstep, voffB); PG8_STAGE(PG8_SA(1, 0), a3, voffA);
            PG8_WAIT_V(8); PG8_WAIT_L(0); PG8_BAR; PG8_MMA(1, 0, At, B0); PG8_MMA(1, 1, At, B1); PG8_BAR; PG8_SCHED;
            } else {
            PG8_LDB(B0, 0, 0); PG8_SCHED; PG8_LDA(At, 0, 0); PG8_STAGE(PG8_SA(1, 1), a1 + hstep, voffA);
            PG8_WAIT_L(8); PG8_BAR; PG8_WAIT_L(0); PG8_MMA(0, 0, At, B0); PG8_BAR; PG8_SCHED;
            PG8_LDB(B1, 0, 1); PG8_STAGE(PG8_SB(0, 0), b2, voffB);
            PG8_BAR; PG8_WAIT_L(0); PG8_MMA(0, 1, At, B1); PG8_BAR;
            PG8_LDA(At, 0, 1); PG8_STAGE(PG8_SA(0, 0), a2, voffA);
            PG8_BAR; PG8_WAIT_L(0); PG8_MMA(1, 0, At, B0); PG8_BAR; PG8_SCHED;
            PG8_STAGE(PG8_SB(0, 1), b2 + hstep, voffB);
            PG8_WAIT_V(6); PG8_BAR; PG8_MMA(1, 1, At, B1); PG8_BAR;
            PG8_LDB(B0, 1, 0); PG8_SCHED; PG8_LDA(At, 1, 0); PG8_STAGE(PG8_SA(0, 1), a2 + hstep, voffA);
            PG8_WAIT_L(8); PG8_BAR; PG8_WAIT_L(0); PG8_MMA(0, 0, At, B0); PG8_BAR; PG8_SCHED;
            PG8_LDB(B1, 1, 1); PG8_STAGE(PG8_SB(1, 0), b3, voffB);
            PG8_BAR; PG8_WAIT_L(0); PG8_MMA(0, 1, At, B1); PG8_BAR;
            PG8_LDA(At, 1, 1); PG8_STAGE(PG8_SA(1, 0), a3, voffA);
            PG8_BAR; PG8_WAIT_L(0); PG8_MMA(1, 0, At, B0); PG8_BAR; PG8_SCHED;
            PG8_STAGE(PG8_SB(1, 1), b3 + hstep, voffB);
            PG8_WAIT_V(6); PG8_BAR; PG8_MMA(1, 1, At, B1); PG8_BAR;
            }
        }
        if constexpr (ALIGN_EPI) { if (wr == 0) PG8_BAR; }
        if constexpr (!Epi::AFTER_DRAIN) { E(acc, cur, wr, wc, fr, fq); S.done(cur); }
        if (!has_next) break;
#pragma unroll
        for (int a = 0; a < 2; ++a)
#pragma unroll
            for (int b = 0; b < 2; ++b)
#pragma unroll
                for (int m = 0; m < 4; ++m)
#pragma unroll
                    for (int n = 0; n < 2; ++n) acc[a][b][m][n] = (f32x4){0.f, 0.f, 0.f, 0.f};
        cur = nxt; cA = nA; cB = nB; ++ui;
        if constexpr (ALIGN_EPI) { if (wr == 1) PG8_BAR; }
    }
    PG8_WAIT_V(0);
    if constexpr (!ALIGN_EPI) { if (wr == 0) PG8_BAR; }
    PG8_BAR;
    if constexpr (Epi::AFTER_DRAIN) { E.fused(acc, cur, wr, wc, fr, fq, lds, wid, lane); S.done(cur); }
#undef PG8_SA
#undef PG8_SB
#undef PG8_STAGE
#undef PG8_LDA
#undef PG8_LDB
#undef PG8_MMA
#undef PG8_WAIT_V
#undef PG8_WAIT_L
#undef PG8_BAR
#undef PG8_SCHED
}
}

namespace mk {
using pg8::bf16_t; using pg8::bf16x8; using pg8::f32x4; using pg8::u32x4; using pg8::u32x2; using pg8::s16x4; using pg8::pk2; using pg8::lo16; using pg8::hi16; using pg8::bf2f;
#define DI __device__ __forceinline__
#define MFMA16(a, b, c) __builtin_amdgcn_mfma_f32_16x16x32_bf16((a), (b), (c), 0, 0, 0)
constexpr int NT = 512;
#ifndef GEMM_SP2
#define GEMM_SP2 true
#endif
#ifndef GEMM_ALIGN
#define GEMM_ALIGN true
#endif
constexpr size_t MiB = (size_t)1 << 20;
constexpr size_t WS_CTL = 0, WS_MOD = 65536, WS_TAB = 512 * 1024, WS_AB = 1 * MiB, WS_AQ = 4 * MiB, WS_AKV = 20 * MiB, WS_DQKV = 29 * MiB, WS_DZ = 83 * MiB, WS_WIN = 99 * MiB, WS_H = 109 * MiB,
                 WS_PREP = 99 * MiB, WS_SC = 243 * MiB, WS_YD = 20 * MiB, WS_OF = 36 * MiB, WS_OB = 52 * MiB, WS_WBR = 99 * MiB, WS_WOUT = 101 * MiB, WS_WM1 = 103 * MiB, WS_WM2 = 111 * MiB,
                 WS_Y = 119 * MiB, WS_H2 = 4 * MiB, WS_ROWSQ = 320 * 1024, WS_BIAS = 384 * 1024, WS_ACT = 119 * MiB, WS_END = 247 * MiB;
constexpr int LDS_BYTES = 131072 + 1024 + 18432;
constexpr float LOG2E = 1.4426950408889634f;

struct Params { const float* in[21]; float* out; unsigned char* ws; };

DI bf16x8 pack8(const f32x4 a, const f32x4 b) { u32x4 r; r.x = pk2(a[0], a[1]); r.y = pk2(a[2], a[3]); r.z = pk2(b[0], b[1]); r.w = pk2(b[2], b[3]); return __builtin_bit_cast(bf16x8, r); }
DI bf16x8 pack8r(const f32x4 a, const f32x4 b) { u32x4 r; r.x = pk2(a[3], a[2]); r.y = pk2(a[1], a[0]); r.z = pk2(b[3], b[2]); r.w = pk2(b[1], b[0]); return __builtin_bit_cast(bf16x8, r); }
DI bf16_t f2bf(float v) { return (bf16_t)(pk2(v, 0.f) & 0xffffu); }
DI float silu(float v) { return v / (1.0f + __expf(-v)); }
#define LBAR() asm volatile("s_waitcnt lgkmcnt(0)\n\ts_barrier" ::: "memory")

struct ConvT { const float* src; bf16_t* dst; int ldsrc, ldk, k0, n0, mode; };
DI void conv_load(const ConvT& c, int tid, float (&r)[16]) {
#pragma unroll
    for (int i = 0; i < 16; ++i) { const int e = tid + NT * i, kk = e >> 7, nn = e & 127, n = c.n0 + nn; int sc = n;
        if (c.mode == 1) { if (n >= 2816 && n < 4864) { const int t = n - 2816, gt = t >> 8, j = t & 255; sc = j < 128 ? 2848 + 128 * gt + j : 3872 + 128 * gt + (j - 128); } else sc = n < 2816 ? n : (n < 4896 ? n - 2048 : -1); }
        r[i] = sc >= 0 ? c.src[(size_t)(c.k0 + kk) * c.ldsrc + sc] : 0.f; }
}
#define CONV_TILES(first, stride, ntiles, DEC, tile, HOOK) do { int tid_ = threadIdx.x; asm volatile("" : "+v"(tid_)); const int ctid = tid_; float cr[16]; int ct = (first); \
    if (ct < (ntiles)) { const ConvT c0 = DEC(ct); conv_load(c0, ctid, cr); } \
    for (; ct < (ntiles); ct += (stride)) { const ConvT cc = DEC(ct); \
        _Pragma("unroll") for (int i = 0; i < 16; ++i) { const int e = ctid + NT * i; (tile)[(e >> 7) * 129 + (e & 127)] = cr[i]; } \
        LBAR(); \
        if (ct + (stride) < (ntiles)) { const ConvT cn = DEC(ct + (stride)); conv_load(cn, ctid, cr); } \
        HOOK(cc, ct, ctid, tile); \
        { const int nn = ctid >> 2, ks = (ctid & 3) * 16; const float* t = (tile) + ks * 129 + nn; u32x4 w0, w1; \
          w0.x = pk2(t[0], t[129]); w0.y = pk2(t[258], t[387]); w0.z = pk2(t[516], t[645]); w0.w = pk2(t[774], t[903]); \
          w1.x = pk2(t[1032], t[1161]); w1.y = pk2(t[1290], t[1419]); w1.z = pk2(t[1548], t[1677]); w1.w = pk2(t[1806], t[1935]); \
          bf16_t* d = cc.dst + (size_t)(cc.n0 + nn) * cc.ldk + cc.k0 + ks; *(u32x4*)d = w0; *(u32x4*)(d + 8) = w1; } \
        LBAR(); } } while (0)
#define NO_HOOK(cc, ct, ctid, tile) do {} while (0)
#define BIAS_HOOK(cc, ct, ctid, tile) do { if ((ct) >= 256 && (ct) < 768) { const int hb_ = __builtin_amdgcn_readfirstlane((ctid) >> 6), hn_ = (ctid) & 63; const float* sh_ = (const float*)(P.ws + WS_MOD) + (size_t)hb_ * 6144 + 3072 + (cc).k0; float ps0_ = 0.f, ps1_ = 0.f; \
        _Pragma("unroll 16") for (int kk_ = 0; kk_ < 64; ++kk_) { const float sv_ = sh_[kk_]; ps0_ += (tile)[kk_ * 129 + hn_] * sv_; ps1_ += (tile)[kk_ * 129 + 64 + hn_] * sv_; } \
        float* bp_ = (float*)(P.ws + WS_BIAS) + hb_ * 4096 + (cc).n0 + hn_; atomicAdd(bp_, ps0_); atomicAdd(bp_ + 64, ps1_); } } while (0)
DI ConvT dec_win(const Params& P, int t) { ConvT c; c.src = P.in[7]; c.dst = (bf16_t*)(P.ws + WS_WIN); c.ldsrc = 4896; c.ldk = 1024; c.k0 = (t & 15) * 64; c.n0 = (t >> 4) * 128; c.mode = 1; return c; }
DI ConvT dec_rest(const Params& P, int t) { ConvT c; c.mode = 0;
    if (t < 128) { const int br = t >> 6, tt = t & 63; c.src = P.in[15 + br]; c.dst = (bf16_t*)(P.ws + WS_WBR) + (size_t)br * 1024 * 512; c.ldsrc = 1024; c.ldk = 512; c.k0 = (tt & 7) * 64; c.n0 = (tt >> 3) * 128; }
    else if (t < 256) { const int tt = t - 128; c.src = P.in[17]; c.dst = (bf16_t*)(P.ws + WS_WOUT); c.ldsrc = 1024; c.ldk = 1024; c.k0 = (tt & 15) * 64; c.n0 = (tt >> 4) * 128; }
    else if (t < 768) { const int tt = t - 256; c.src = P.in[19]; c.dst = (bf16_t*)(P.ws + WS_WM1); c.ldsrc = 4096; c.ldk = 1024; c.k0 = (tt & 15) * 64; c.n0 = (tt >> 4) * 128; }
    else { const int tt = t - 768; c.src = P.in[20]; c.dst = (bf16_t*)(P.ws + WS_WM2); c.ldsrc = 1024; c.ldk = 4096; c.k0 = (tt & 63) * 64; c.n0 = (tt >> 6) * 128; }
    return c; }
DI void mod_item(const Params& P, int item, float* sil) {
    const int tid = threadIdx.x, ns = item % 12, ksl = item / 12;
    if (tid < 144) { const int r = tid >> 4, kk = tid & 15; const float v = r < 8 ? P.in[1][r * 1024 + ksl * 16 + kk] : P.in[3][ksl * 16 + kk]; sil[tid] = v / (1.0f + expf(-v)); }
    const int n = ns * 512 + tid; const float* w = P.in[4] + (size_t)(ksl * 16) * 6144 + n; float wv[16];
#pragma unroll
    for (int kk = 0; kk < 16; ++kk) wv[kk] = w[(size_t)kk * 6144];
    __syncthreads();
    float acc[9];
#pragma unroll
    for (int r = 0; r < 9; ++r) acc[r] = 0.f;
#pragma unroll
    for (int kk = 0; kk < 16; ++kk)
#pragma unroll
        for (int r = 0; r < 9; ++r) acc[r] += sil[r * 16 + kk] * wv[kk];
    float* mod = (float*)(P.ws + WS_MOD); const float bias = ksl == 0 ? P.in[5][n] : 0.f;
#pragma unroll
    for (int r = 0; r < 9; ++r) atomicAdd(mod + r * 6144 + n, acc[r] + bias);
    __syncthreads();
}

DI void modnorm_rows(const float* src_lat, const float* src_ctx, int nrows, const float* g, const float* mod, int sh_off, int sc_off, bf16_t* dst) {
    const int wave = threadIdx.x >> 6, lane = threadIdx.x & 63; const int stride = gridDim.x * 8;
    int row = blockIdx.x * 8 + wave; f32x4 v[4];
    if (row < nrows) { const float* src = row < 16384 ? src_lat + (size_t)row * 1024 : src_ctx + (size_t)(row - 16384) * 1024;
#pragma unroll
        for (int j = 0; j < 4; ++j) v[j] = *(const f32x4*)(src + j * 256 + lane * 4); }
    for (; row < nrows; row += stride) {
        const int nrow = row + stride; f32x4 vn[4];
#pragma unroll
        for (int j = 0; j < 4; ++j) vn[j] = v[j];
        if (nrow < nrows) { const float* src = nrow < 16384 ? src_lat + (size_t)nrow * 1024 : src_ctx + (size_t)(nrow - 16384) * 1024;
#pragma unroll
            for (int j = 0; j < 4; ++j) vn[j] = *(const f32x4*)(src + j * 256 + lane * 4); }
        const float* mr = mod + (size_t)(row < 16384 ? (row >> 11) : 8) * 6144; float ss = 0.f;
#pragma unroll
        for (int j = 0; j < 4; ++j) ss += v[j][0] * v[j][0] + v[j][1] * v[j][1] + v[j][2] * v[j][2] + v[j][3] * v[j][3];
#pragma unroll
        for (int off = 32; off >= 1; off >>= 1) ss += __shfl_xor(ss, off);
        const float rstd = rsqrtf(ss * (1.0f / 1024.0f) + 1e-6f);
#pragma unroll
        for (int j = 0; j < 4; ++j) { const int col = j * 256 + lane * 4; const f32x4 gg = *(const f32x4*)(g + col), sc = *(const f32x4*)(mr + sc_off + col), sh = *(const f32x4*)(mr + sh_off + col);
            const f32x4 hh = v[j] * rstd * gg * (sc + 1.0f) + sh; u32x2 w; w.x = pk2(hh[0], hh[1]); w.y = pk2(hh[2], hh[3]); *(u32x2*)(dst + (size_t)row * 1024 + col) = w; }
#pragma unroll
        for (int j = 0; j < 4; ++j) v[j] = vn[j];
    }
}

DI int frag_idx(int row, int k) { return ((((row >> 4) * 2 + (k >> 5)) * 64) + (((k & 15) >> 2) * 16 + (row & 15))) * 8 + ((k >> 4) & 1) * 4 + (k & 3); }
DI float silu_fast(float v) { return v * __builtin_amdgcn_rcpf(1.0f + __expf(-v)); }
DI void prep_phase(const Params& P, unsigned char* smem) {
    int tid_ = threadIdx.x; asm volatile("" : "+v"(tid_)); const int tid = tid_, half = tid >> 8, hid = tid & 255, lane = tid & 63, w4 = (tid >> 6) & 3, dir = half;
    const int r2 = half, r4a = 2 + half;
    unsigned char* hb = smem + half * 64256;
    bf16_t* sQ = (bf16_t*)hb; bf16_t* sK = sQ + 64 * 72; bf16_t* sV = sK + 64 * 72; bf16_t* sAn = sV + 64 * 72; bf16_t* sXt = sAn + 64 * 72; float* sAd = (float*)(hb + 55296); bf16_t* sD = (bf16_t*)(hb + 60416);
    float* sG = (float*)(hb + 63488); float* sBeta = sG + 64; float* sEG = sBeta + 64;
    const bf16_t* DQKV = (const bf16_t*)(P.ws + WS_DQKV); const float* AB = (const float*)(P.ws + WS_AB);
    float* sCW = (float*)(smem + 132096);
    for (int e = tid; e < 1152; e += NT) *(f32x4*)(sCW + e * 4) = *(const f32x4*)(P.in[11] + e * 4);
    const float r_alog = P.in[12][lane & 15], r_dtb = P.in[13][lane & 15];
    LBAR();
    u32x4 ra[3][3]; float rda = 0.f, rdb = 0.f;
#define PREP_LOAD(it) do { const int ci_ = (it) % 36, bh_ = (it) / 36, h_ = bh_ & 7, b_ = bh_ >> 3; const bool lat_ = ci_ >= 4; \
        const int sb_ = lat_ ? b_ * 2048 : 16384 + b_ * 256, sl_ = lat_ ? 2048 : 256, t0_ = lat_ ? (ci_ - 4) * 64 : ci_ * 64, t_ = t0_ + (tid >> 3); \
        _Pragma("unroll") for (int tap = 0; tap < 3; ++tap) { int tt = t_ + tap - 1; tt = tt < 0 ? 0 : (tt >= sl_ ? sl_ - 1 : tt); const bf16_t* pr = DQKV + (size_t)(sb_ + tt) * 1536 + h_ * 64 + (tid & 7) * 8; \
            _Pragma("unroll") for (int T = 0; T < 3; ++T) ra[T][tap] = *(const u32x4*)(pr + T * 512); } \
        if (w4 == r2) { const int tl_ = t0_ + (dir ? 63 - lane : lane); const float* ab_ = AB + (size_t)(sb_ + tl_) * 32; const int j_ = dir * 8 + h_; rda = ab_[j_]; rdb = ab_[16 + j_]; } } while (0)
    if ((int)blockIdx.x < 2304) PREP_LOAD((int)blockIdx.x);
    for (int item = blockIdx.x; item < 2304; item += gridDim.x) {
    const int ci = item % 36, bh = item / 36, h = bh & 7; const bool lat = ci >= 4;
    const int seqlen = lat ? 2048 : 256, t0 = lat ? (ci - 4) * 64 : ci * 64;
    unsigned char* rec = P.ws + WS_PREP + (size_t)item * 65536;
    bf16_t* Wp = (bf16_t*)(rec + 16384 + dir * 24576); bf16_t* Up = Wp + 4096; bf16_t* Ip = Up + 4096;
    float* sc = (float*)(P.ws + WS_SC) + (size_t)(item * 2 + dir) * 192;
    { const int c = tid >> 3, seg = tid & 7, t = t0 + c;
      float mk[3]; mk[0] = t - 1 >= 0 ? 1.0f : 0.0f; mk[1] = 1.0f; mk[2] = t + 1 < seqlen ? 1.0f : 0.0f;
#pragma unroll
      for (int T = 0; T < 3; ++T) {
          float y[8];
#pragma unroll
          for (int e = 0; e < 8; ++e) y[e] = 0.f;
          const float* cw = sCW + T * 512 + h * 64 + seg * 8;
#pragma unroll
          for (int tap = 0; tap < 3; ++tap) { const u32x4 a0 = ra[T][tap]; const float* w = cw + tap * 1536; const float m = mk[tap];
              const f32x4 w0 = *(const f32x4*)w * m, w1 = *(const f32x4*)(w + 4) * m;
              y[0] += w0[0] * lo16(a0.x); y[1] += w0[1] * hi16(a0.x); y[2] += w0[2] * lo16(a0.y); y[3] += w0[3] * hi16(a0.y); y[4] += w1[0] * lo16(a0.z); y[5] += w1[1] * hi16(a0.z); y[6] += w1[2] * lo16(a0.w); y[7] += w1[3] * hi16(a0.w); }
#pragma unroll
          for (int e = 0; e < 8; ++e) { y[e] = silu_fast(y[e]); if (T == 0 && !lat) y[e] = 0.f; }
          if (T < 2) { float ss = 0.f;
#pragma unroll
              for (int e = 0; e < 8; ++e) ss += y[e] * y[e];
              ss += __shfl_xor(ss, 1); ss += __shfl_xor(ss, 2); ss += __shfl_xor(ss, 4); const float sn = rsqrtf(ss + 1e-6f) * (T == 0 ? 0.125f : 1.0f);
#pragma unroll
              for (int e = 0; e < 8; ++e) y[e] *= sn; }
          u32x4 o0; o0.x = pk2(y[0], y[1]); o0.y = pk2(y[2], y[3]); o0.z = pk2(y[4], y[5]); o0.w = pk2(y[6], y[7]);
          const int toff = T * 64 * 72 + seg * 8;
          *(u32x4*)((bf16_t*)smem + toff + c * 72) = o0; *(u32x4*)((bf16_t*)(smem + 64256) + toff + (63 - c) * 72) = o0;
      } }
    if (w4 == r2) { const int c = lane; const int j = dir * 8 + h;
        const float xa = rda + __shfl(r_dtb, j); const float sp = xa > 20.f ? xa : log1pf(__expf(xa));
        float G = -__expf(__shfl(r_alog, j)) * sp; const float beta = __builtin_amdgcn_rcpf(1.0f + __expf(-rdb));
#pragma unroll
        for (int off = 1; off < 64; off <<= 1) { const float v = __shfl_up(G, off); if (lane >= off) G += v; }
        const float gl = __shfl(G, 63), eg = __expf(G);
        sG[c] = G; sBeta[c] = beta; sEG[c] = eg; sc[c] = eg; sc[64 + c] = __expf(gl - G); if (c == 0) sc[128] = __expf(gl); }
    LBAR();
    if (item + (int)gridDim.x < 2304) PREP_LOAD(item + (int)gridDim.x);
    { const int r16 = lane & 15, q = lane >> 4, mb = w4; f32x4 kk[4], kq[4];
#pragma unroll
      for (int nb = 0; nb < 4; ++nb) { kk[nb] = (f32x4){0.f, 0.f, 0.f, 0.f}; kq[nb] = (f32x4){0.f, 0.f, 0.f, 0.f}; }
#pragma unroll
      for (int ks = 0; ks < 2; ++ks) { const bf16x8 ak = *(const bf16x8*)(sK + (16 * mb + r16) * 72 + 32 * ks + 8 * q);
#pragma unroll
          for (int nb = 0; nb < 4; ++nb) { const bf16x8 bk = *(const bf16x8*)(sK + (16 * nb + r16) * 72 + 32 * ks + 8 * q), bq = *(const bf16x8*)(sQ + (16 * nb + r16) * 72 + 32 * ks + 8 * q);
              kk[nb] = MFMA16(ak, bk, kk[nb]); kq[nb] = MFMA16(ak, bq, kq[nb]); } }
#pragma unroll
      for (int nb = 0; nb < 4; ++nb) {
#pragma unroll
          for (int i = 0; i < 4; ++i) { const int ri = 16 * mb + 4 * q + i, cj = 16 * nb + r16; float a = 0.f;
              if (nb <= mb) a = cj < ri ? sBeta[ri] * __expf(fminf(sG[ri] - sG[cj], 0.f)) * kk[nb][i] : 0.f;
              sAn[ri * 72 + cj] = f2bf(-a); if (nb == mb) sAd[(mb * 16 + 4 * q + i) * 20 + r16] = a; }
          if (lat && nb < mb) { *(u32x2*)(Ip + frag_idx(16 * nb + r16, 16 * mb + 4 * q)) = (u32x2){0u, 0u}; }
          if (lat && nb >= mb) { const int ri = 16 * nb + r16; const float gi = sG[ri]; float iv[4];
#pragma unroll
              for (int i = 0; i < 4; ++i) { const int cj = 16 * mb + 4 * q + i; iv[i] = cj <= ri ? __expf(fminf(gi - sG[cj], 0.f)) * kq[nb][i] : 0.f; }
              u32x2 wv; wv.x = pk2(iv[0], iv[1]); wv.y = pk2(iv[2], iv[3]); *(u32x2*)(Ip + frag_idx(ri, 16 * mb + 4 * q)) = wv; } }
    }
    LBAR();
    if (w4 == r4a) { const int bb = lane >> 4, j = lane & 15; float x[16];
        typedef __attribute__((address_space(3))) const f32x4* lcf4; const lcf4 ad = (lcf4)(sAd + bb * 16 * 20);
        x[0] = j == 0 ? 1.0f : 0.0f;
#define DIAG_ROWS(lo, hi) do { f32x4 ar[(hi) - (lo)][4]; \
        _Pragma("unroll") for (int i = (lo); i < (hi); ++i) _Pragma("unroll") for (int k4 = 0; k4 < i; k4 += 4) ar[i - (lo)][k4 >> 2] = ad[i * 5 + (k4 >> 2)]; \
        _Pragma("unroll") for (int i = (lo); i < (hi); ++i) { float sv = i == j ? 1.0f : 0.0f; \
            _Pragma("unroll") for (int k4 = 0; k4 < i; k4 += 4) { const f32x4 a = ar[i - (lo)][k4 >> 2]; sv -= a[0] * x[k4]; if (k4 + 1 < i) sv -= a[1] * x[k4 + 1]; if (k4 + 2 < i) sv -= a[2] * x[k4 + 2]; if (k4 + 3 < i) sv -= a[3] * x[k4 + 3]; } \
            x[i] = sv; } } while (0)
        DIAG_ROWS(1, 9); DIAG_ROWS(9, 13); DIAG_ROWS(13, 16);
#undef DIAG_ROWS
#pragma unroll
        for (int i = 0; i < 16; ++i) sD[(bb * 16 + i) * 24 + j] = f2bf(x[i]);
    } else { const int rk = (w4 - (w4 > r4a ? 1 : 0)) * 64 + lane;
      if (dir == 0) { bf16_t* Qf = (bf16_t*)rec; bf16_t* KTf = Qf + 4096;
        for (int fid = rk; fid < 512; fid += 192) { const int fmb = fid >> 7, ks = (fid >> 6) & 1, lf = fid & 63, qf = lf >> 4, fr = lf & 15; const int row = 16 * fmb + fr, k0 = 32 * ks + 4 * qf;
            if (lat) { const u32x2 a = *(const u32x2*)(sQ + row * 72 + k0), bq = *(const u32x2*)(sQ + row * 72 + k0 + 16); u32x4 wv; wv.x = a.x; wv.y = a.y; wv.z = bq.x; wv.w = bq.y; *(u32x4*)(Qf + fid * 8) = wv; }
            u32x4 wv; const bf16_t* kc = sK + row;
            wv.x = (unsigned)kc[(k0 + 0) * 72] | ((unsigned)kc[(k0 + 1) * 72] << 16); wv.y = (unsigned)kc[(k0 + 2) * 72] | ((unsigned)kc[(k0 + 3) * 72] << 16);
            wv.z = (unsigned)kc[(k0 + 16) * 72] | ((unsigned)kc[(k0 + 17) * 72] << 16); wv.w = (unsigned)kc[(k0 + 18) * 72] | ((unsigned)kc[(k0 + 19) * 72] << 16);
            *(u32x4*)(KTf + fid * 8) = wv; } }
      for (int o = rk; o < 1024; o += 192) *(u32x4*)(sXt + (o >> 3) * 72 + (o & 7) * 8) = (u32x4){0u, 0u, 0u, 0u};
    }
    LBAR();
    { const int r16 = lane & 15, q = lane >> 4;
#pragma unroll
      for (int bb = 0; bb < 4; ++bb) {
          f32x4 be;
#pragma unroll
          for (int i = 0; i < 4; ++i) { const int ri = 16 * bb + 4 * q + i; be[i] = w4 < 2 ? sBeta[ri] * sEG[ri] : sBeta[ri]; }
          const u32x2 dq = *(const u32x2*)(sD + (bb * 16 + r16) * 24 + 4 * q); u32x4 dfr; dfr.x = dq.x; dfr.y = dq.y; dfr.z = 0u; dfr.w = 0u;
#pragma unroll
          for (int t = 0; t < 2; ++t) { const int n0 = 32 * w4 + 16 * t + r16; const bf16_t* rsrc = (w4 < 2 ? sK + n0 : sV + (n0 - 64)) + (16 * bb + 4 * q) * 72;
              f32x4 acc; acc[0] = be[0] * bf2f(rsrc[0]); acc[1] = be[1] * bf2f(rsrc[72]); acc[2] = be[2] * bf2f(rsrc[144]); acc[3] = be[3] * bf2f(rsrc[216]);
#pragma unroll
              for (int ks = 0; ks < (bb + 1) / 2; ++ks) acc = MFMA16(*(const bf16x8*)(sAn + (16 * bb + r16) * 72 + 32 * ks + 8 * q), *(const bf16x8*)(sXt + n0 * 72 + 32 * ks + 8 * q), acc);
              u32x4 yb; yb.x = pk2(acc[0], acc[1]); yb.y = pk2(acc[2], acc[3]); yb.z = 0u; yb.w = 0u;
              const f32x4 z = MFMA16(__builtin_bit_cast(bf16x8, dfr), __builtin_bit_cast(bf16x8, yb), ((f32x4){0.f, 0.f, 0.f, 0.f}));
              u32x2 zw; zw.x = pk2(z[0], z[1]); zw.y = pk2(z[2], z[3]);
              *(u32x2*)(sXt + n0 * 72 + 16 * bb + 4 * q) = zw;
              if (w4 >= 2) { const int vs = 2 * (w4 - 2) + t; *(u32x2*)(Up + ((vs * 4 + bb) * 64 + lane) * 4) = zw; } }
          asm volatile("s_waitcnt lgkmcnt(0)" ::: "memory");
      }
      if (w4 < 2) {
#pragma unroll
          for (int mb = 0; mb < 4; ++mb) { const bf16_t* xc = sXt + (32 * w4 + 4 * q) * 72 + 16 * mb + r16; u32x4 wv;
              wv.x = ((unsigned)xc[0] | ((unsigned)xc[72] << 16)) ^ 0x80008000u; wv.y = ((unsigned)xc[144] | ((unsigned)xc[216] << 16)) ^ 0x80008000u;
              wv.z = ((unsigned)xc[16 * 72] | ((unsigned)xc[17 * 72] << 16)) ^ 0x80008000u; wv.w = ((unsigned)xc[18 * 72] | ((unsigned)xc[19 * 72] << 16)) ^ 0x80008000u;
              *(u32x4*)(Wp + ((mb * 2 + w4) * 64 + lane) * 8) = wv; } }
    }
    LBAR();
    }
}

DI void qk_normrope(const Params& P) {
    bf16_t* AQ = (bf16_t*)(P.ws + WS_AQ); bf16_t* AKV = (bf16_t*)(P.ws + WS_AKV); const float* TAB = (const float*)(P.ws + WS_TAB);
    for (int task = blockIdx.x * NT + threadIdx.x; task < 131072 + 36864; task += gridDim.x * NT) {
        bf16_t* ptr; const float* g; bool rope; int pos; float extra;
        if (task < 131072) { const int row = task >> 3, hd = task & 7; ptr = AQ + (size_t)row * 512 + hd * 64; g = P.in[8]; rope = true; pos = row & 2047; extra = 0.125f * LOG2E; }
        else { const int t2 = task - 131072, row = t2 >> 1, hd = t2 & 1; ptr = AKV + (size_t)row * 256 + hd * 64; g = P.in[9]; rope = row < 16384; pos = row & 2047; extra = 1.0f; }
        float v[64]; float ss = 0.f;
#pragma unroll
        for (int j = 0; j < 8; ++j) { const u32x4 a = *(const u32x4*)(ptr + j * 8); v[j * 8 + 0] = lo16(a.x); v[j * 8 + 1] = hi16(a.x); v[j * 8 + 2] = lo16(a.y); v[j * 8 + 3] = hi16(a.y); v[j * 8 + 4] = lo16(a.z); v[j * 8 + 5] = hi16(a.z); v[j * 8 + 6] = lo16(a.w); v[j * 8 + 7] = hi16(a.w); }
#pragma unroll
        for (int d = 0; d < 64; ++d) ss += v[d] * v[d];
        const float rs = rsqrtf(ss * (1.0f / 64.0f) + 1e-6f);
#pragma unroll
        for (int d = 0; d < 64; ++d) v[d] = v[d] * rs * g[d];
        if (rope) { const float* tr = TAB + (size_t)(pos >> 6) * 32; const float* tc = TAB + (size_t)(pos & 63) * 32;
#pragma unroll
            for (int f = 0; f < 16; ++f) { const float c1 = tr[2 * f], s1 = tr[2 * f + 1], c2 = tc[2 * f], s2 = tc[2 * f + 1];
                const float a1 = v[f], a2 = v[16 + f], b1 = v[32 + f], b2 = v[48 + f];
                v[f] = a1 * c1 - a2 * s1; v[16 + f] = a1 * s1 + a2 * c1; v[32 + f] = b1 * c2 - b2 * s2; v[48 + f] = b1 * s2 + b2 * c2; } }
#pragma unroll
        for (int j = 0; j < 8; ++j) { u32x4 w; w.x = pk2(v[j * 8] * extra, v[j * 8 + 1] * extra); w.y = pk2(v[j * 8 + 2] * extra, v[j * 8 + 3] * extra); w.z = pk2(v[j * 8 + 4] * extra, v[j * 8 + 5] * extra); w.w = pk2(v[j * 8 + 6] * extra, v[j * 8 + 7] * extra);
            *(u32x4*)(ptr + j * 8) = w; }
    }
}

#define SC_LAS __attribute__((address_space(3)))
DI int scan_chunk(int dir, int p) { return dir == 0 ? p : (p < 4 ? 3 - p : 39 - p); }
DI void scan_block(const Params& P, int sb, unsigned char* smem) {
    int tid_ = threadIdx.x; asm volatile("" : "+v"(tid_)); const int tid = tid_, lane = tid & 63, r16 = lane & 15, q = lane >> 4;
    const int w = __builtin_amdgcn_readfirstlane(tid >> 6), pair = sb >> 1, dir = sb & 1; const int b = pair >> 3, h = pair & 7;
    SC_LAS unsigned char* L = (SC_LAS unsigned char*)smem;
    const unsigned char* prep = P.ws + WS_PREP + (size_t)pair * 36 * 65536;
    __syncthreads();
    if (w >= 4) {
        const int m = w - 4; const int moff = m == 0 ? 16384 + dir * 24576 : (m == 1 ? 0 : (m == 2 ? 32768 + dir * 24576 : 8192));
#define SCAN_DMA(pp) do { const unsigned char* src_ = prep + (size_t)scan_chunk(dir, (pp)) * 65536 + moff + lane * 16; SC_LAS unsigned char* dst_ = L + ((pp) % 3) * 32768 + m * 8192; \
        _Pragma("unroll") for (int i_ = 0; i_ < 8; ++i_) __builtin_amdgcn_global_load_lds((const unsigned*)(src_ + i_ * 1024), (SC_LAS unsigned*)(dst_ + i_ * 1024), 16, 0, 0); } while (0)
        SCAN_DMA(0); SCAN_DMA(1);
        for (int p = 0; p < 36; ++p) {
            if (p + 1 < 36) asm volatile("s_waitcnt vmcnt(8)" ::: "memory"); else asm volatile("s_waitcnt vmcnt(0)" ::: "memory");
            __builtin_amdgcn_s_barrier();
            if (p + 2 < 36) SCAN_DMA(p + 2);
        }
#undef SCAN_DMA
    } else {
        const int vs = w; bf16_t* Oout = (bf16_t*)(P.ws + (dir ? WS_OB : WS_OF)); const float* scb = (const float*)(P.ws + WS_SC) + (size_t)pair * 36 * 2 * 192 + dir * 192;
#define SCAN_LDREG(pp, Ur, Eg, Tl, Egl) do { const int ci_ = scan_chunk(dir, (pp)); const bf16_t* Up_ = (const bf16_t*)(prep + (size_t)ci_ * 65536 + 16384 + dir * 24576 + 8192); const float* sc_ = scb + (size_t)ci_ * 384; \
        _Pragma("unroll") for (int mb_ = 0; mb_ < 4; ++mb_) { Ur[mb_] = *(const u32x2*)(Up_ + ((vs * 4 + mb_) * 64 + lane) * 4); Eg[mb_] = *(const f32x4*)(sc_ + 16 * mb_ + 4 * q); Tl[mb_] = *(const f32x4*)(sc_ + 64 + 16 * mb_ + 4 * q); } \
        Egl = sc_[128]; } while (0)
        f32x4 S[4];
#pragma unroll
        for (int r = 0; r < 4; ++r) S[r] = (f32x4){0.f, 0.f, 0.f, 0.f};
        u32x2 Uc[4]; f32x4 Egc[4], Tlc[4]; float Eglc; u32x2 opk[4]; int otb = -1;
#pragma unroll
        for (int mb = 0; mb < 4; ++mb) { opk[mb].x = 0u; opk[mb].y = 0u; }
#define SCAN_OSTORE() do { _Pragma("unroll") for (int mb_ = 0; mb_ < 4; ++mb_) { const int cp_ = 16 * mb_ + 4 * q; bf16_t* ob_ = Oout + (size_t)otb * 512 + h * 64 + 16 * vs + r16; const int st_ = dir ? -512 : 512; ob_ += (dir ? 63 - cp_ : cp_) * 512; \
        ob_[0] = (bf16_t)(opk[mb_].x & 0xffffu); ob_[st_] = (bf16_t)(opk[mb_].x >> 16); ob_[2 * st_] = (bf16_t)(opk[mb_].y & 0xffffu); ob_[3 * st_] = (bf16_t)(opk[mb_].y >> 16); } } while (0)
        SCAN_LDREG(0, Uc, Egc, Tlc, Eglc);
        for (int p = 0; p < 36; ++p) {
            asm volatile("s_waitcnt vmcnt(0)" ::: "memory"); __builtin_amdgcn_s_barrier(); asm volatile("" ::: "memory");
            if (otb >= 0) { SCAN_OSTORE(); otb = -1; }
            u32x2 Un[4]; f32x4 Egn[4], Tln[4]; float Egln = 0.f;
#pragma unroll
            for (int mb = 0; mb < 4; ++mb) { Un[mb] = Uc[mb]; Egn[mb] = Egc[mb]; Tln[mb] = Tlc[mb]; }
            if (p + 1 < 36) { SCAN_LDREG(p + 1, Un, Egn, Tln, Egln); }
            const int ci = scan_chunk(dir, p); const bool lat = ci >= 4;
            const SC_LAS unsigned char* B0 = L + (p % 3) * 32768;
#define SCAN_FRAG(m, idx) (*(const SC_LAS bf16x8*)(B0 + (m) * 8192 + (idx) * 16))
            bf16x8 Sb[2]; Sb[0] = pack8(S[0], S[1]); Sb[1] = pack8(S[2], S[3]);
            f32x4 u[4];
#pragma unroll
            for (int mb = 0; mb < 4; ++mb) { u[mb][0] = lo16(Uc[mb].x); u[mb][1] = hi16(Uc[mb].x); u[mb][2] = lo16(Uc[mb].y); u[mb][3] = hi16(Uc[mb].y); }
#pragma unroll
            for (int mb = 0; mb < 4; ++mb)
#pragma unroll
                for (int ks = 0; ks < 2; ++ks) u[mb] = MFMA16(SCAN_FRAG(0, (mb * 2 + ks) * 64 + lane), Sb[ks], u[mb]);
            if (lat) {
                f32x4 o[4];
#pragma unroll
                for (int mb = 0; mb < 4; ++mb) { o[mb] = (f32x4){0.f, 0.f, 0.f, 0.f};
#pragma unroll
                    for (int ks = 0; ks < 2; ++ks) { const int qi = dir ? (((3 - mb) * 2 + ks) * 64 + (lane ^ 15)) : ((mb * 2 + ks) * 64 + lane); o[mb] = MFMA16(SCAN_FRAG(1, qi), Sb[ks], o[mb]); }
                    o[mb] = o[mb] * Egc[mb]; }
                bf16x8 ub[2]; ub[0] = pack8(u[0], u[1]); ub[1] = pack8(u[2], u[3]);
#pragma unroll
                for (int mb = 0; mb < 4; ++mb)
#pragma unroll
                    for (int ks = 0; ks < 2; ++ks) o[mb] = MFMA16(SCAN_FRAG(2, (mb * 2 + ks) * 64 + lane), ub[ks], o[mb]);
                otb = b * 2048 + (ci - 4) * 64;
#pragma unroll
                for (int mb = 0; mb < 4; ++mb) { opk[mb].x = pk2(o[mb][0], o[mb][1]); opk[mb].y = pk2(o[mb][2], o[mb][3]); }
            }
            f32x4 u2[4];
#pragma unroll
            for (int mb = 0; mb < 4; ++mb) u2[mb] = u[mb] * Tlc[mb];
            bf16x8 ub2[2]; int kl;
            if (dir == 0) { ub2[0] = pack8(u2[0], u2[1]); ub2[1] = pack8(u2[2], u2[3]); kl = lane; }
            else { ub2[0] = pack8r(u2[3], u2[2]); ub2[1] = pack8r(u2[1], u2[0]); kl = (3 - q) * 16 + r16; }
#pragma unroll
            for (int r = 0; r < 4; ++r) { S[r] = S[r] * Eglc;
#pragma unroll
                for (int ks = 0; ks < 2; ++ks) S[r] = MFMA16(SCAN_FRAG(3, (r * 2 + ks) * 64 + kl), ub2[ks], S[r]); }
#pragma unroll
            for (int mb = 0; mb < 4; ++mb) { Uc[mb] = Un[mb]; Egc[mb] = Egn[mb]; Tlc[mb] = Tln[mb]; }
            Eglc = Egln;
        }
        if (otb >= 0) { SCAN_OSTORE(); }
#undef SCAN_OSTORE
#undef SCAN_FRAG
#undef SCAN_LDREG
    }
    asm volatile("s_waitcnt vmcnt(0) lgkmcnt(0)" ::: "memory"); __syncthreads();
}

DI void attn_phase(const Params& P, unsigned char* smem, unsigned* ctr, volatile int* sItem) {
    int tid_ = threadIdx.x; asm volatile("" : "+v"(tid_)); const int tid = tid_, w = tid >> 6, lane = tid & 63, r16 = lane & 15, q = lane >> 4;
    bf16_t* AQ = (bf16_t*)(P.ws + WS_AQ); const bf16_t* AKV = (const bf16_t*)(P.ws + WS_AKV);
    bf16_t* sK = (bf16_t*)smem; bf16_t* sVt = sK + 2 * 64 * 72;
    const int key = tid >> 3, seg = tid & 7;
    LBAR(); if (tid == 0) sItem[0] = (int)atomicAdd(ctr, 1u); LBAR();
    int item = sItem[0]; if (item >= 1024) return;
    bf16x8 Qb[2]; u32x4 kreg, vreg;
#define ATT_FIRST(it, Q0, Q1) do { const int b_ = (it) >> 7, qb_ = ((it) >> 3) & 15, hd_ = (it) & 7, q0_ = qb_ * 128, lo_ = q0_ - 128 < 0 ? 0 : q0_ - 128; \
        const bf16_t* qr_ = AQ + (size_t)(b_ * 2048 + q0_ + 16 * w + r16) * 512 + hd_ * 64; Q0 = *(const bf16x8*)(qr_ + 8 * q); Q1 = *(const bf16x8*)(qr_ + 32 + 8 * q); \
        const bf16_t* kp_ = AKV + (size_t)(b_ * 2048 + lo_ + key) * 256 + (hd_ >> 2) * 64 + seg * 8; kreg = *(const u32x4*)kp_; vreg = *(const u32x4*)(kp_ + 128); } while (0)
    ATT_FIRST(item, Qb[0], Qb[1]);
    for (;;) {
        if (tid == 0) sItem[1] = (int)atomicAdd(ctr, 1u);
        const int b = item >> 7, qb = (item >> 3) & 15, head = item & 7, g = head >> 2, q0 = qb * 128;
        const int qpos = q0 + 16 * w + r16; bf16_t* qrow = AQ + (size_t)(b * 2048 + qpos) * 512 + head * 64;
        float m = P.in[10][head] * LOG2E, l = q == 0 ? 1.0f : 0.0f; f32x4 O[4];
#pragma unroll
        for (int mb = 0; mb < 4; ++mb) O[mb] = (f32x4){0.f, 0.f, 0.f, 0.f};
        const int lo = q0 - 128 < 0 ? 0 : q0 - 128, hi = q0 + 256 > 2048 ? 2048 : q0 + 256, nloc = (hi - lo) >> 6, ntile = nloc + 4;
        int nxt = 1024; bf16x8 Qn[2]; Qn[0] = Qb[0]; Qn[1] = Qb[1];
        for (int j = 0; j < ntile; ++j) {
            const int buf = j & 1; bf16_t* bK = sK + buf * 64 * 72; bf16_t* bV = sVt + buf * 64 * 76;
            *(u32x4*)(bK + key * 72 + seg * 8) = kreg;
            { bf16_t* vp = bV + (seg * 8) * 76 + key; vp[0] = (bf16_t)(vreg.x & 0xffffu); vp[76] = (bf16_t)(vreg.x >> 16); vp[152] = (bf16_t)(vreg.y & 0xffffu); vp[228] = (bf16_t)(vreg.y >> 16);
              vp[304] = (bf16_t)(vreg.z & 0xffffu); vp[380] = (bf16_t)(vreg.z >> 16); vp[456] = (bf16_t)(vreg.w & 0xffffu); vp[532] = (bf16_t)(vreg.w >> 16); }
            LBAR();
            if (j == 0) nxt = sItem[1];
            if (j + 1 < ntile) { const int jn = j + 1; const int rb = jn < nloc ? b * 2048 + lo + 64 * jn : 16384 + b * 256 + 64 * (jn - nloc);
                const bf16_t* kp = AKV + (size_t)(rb + key) * 256 + g * 64 + seg * 8; kreg = *(const u32x4*)kp; vreg = *(const u32x4*)(kp + 128); }
            else if (nxt < 1024) { ATT_FIRST(nxt, Qn[0], Qn[1]); }
            const int kt0 = lo + 64 * j, qw0 = q0 + 16 * w;
            if (j < nloc && (kt0 + 63 < qw0 - 128 || kt0 > qw0 + 15 + 128)) continue;
            f32x4 s[4];
#pragma unroll
            for (int mb = 0; mb < 4; ++mb) { s[mb] = (f32x4){0.f, 0.f, 0.f, 0.f};
#pragma unroll
                for (int ks = 0; ks < 2; ++ks) s[mb] = MFMA16(*(const bf16x8*)(bK + (16 * mb + r16) * 72 + 32 * ks + 8 * q), Qb[ks], s[mb]); }
            if (j < nloc && (kt0 < qw0 + 15 - 128 || kt0 + 63 > qw0 + 128)) { const int kp0 = lo + 64 * j + 4 * q;
#pragma unroll
                for (int mb = 0; mb < 4; ++mb)
#pragma unroll
                    for (int i = 0; i < 4; ++i) { const int d = qpos - (kp0 + 16 * mb + i); if (d > 128 || d < -128) s[mb][i] = -1e30f; } }
            float tmax = -1e30f;
#pragma unroll
            for (int mb = 0; mb < 4; ++mb)
#pragma unroll
                for (int i = 0; i < 4; ++i) tmax = fmaxf(tmax, s[mb][i]);
            tmax = fmaxf(tmax, __shfl_xor(tmax, 16)); tmax = fmaxf(tmax, __shfl_xor(tmax, 32));
            const float mnew = fmaxf(m, tmax), alpha = __builtin_amdgcn_exp2f(m - mnew); m = mnew; float ls = 0.f;
#pragma unroll
            for (int mb = 0; mb < 4; ++mb)
#pragma unroll
                for (int i = 0; i < 4; ++i) { const float pv = __builtin_amdgcn_exp2f(s[mb][i] - mnew); s[mb][i] = pv; ls += pv; }
            l = l * alpha + ls;
#pragma unroll
            for (int mb = 0; mb < 4; ++mb) O[mb] = O[mb] * alpha;
            bf16x8 pb[2]; pb[0] = pack8(s[0], s[1]); pb[1] = pack8(s[2], s[3]);
#pragma unroll
            for (int mb = 0; mb < 4; ++mb)
#pragma unroll
                for (int ks = 0; ks < 2; ++ks) { const bf16_t* vp = bV + (16 * mb + r16) * 76 + 32 * ks + 4 * q; const u32x2 a = *(const u32x2*)vp, c2 = *(const u32x2*)(vp + 16); u32x4 av; av.x = a.x; av.y = a.y; av.z = c2.x; av.w = c2.y;
                    O[mb] = MFMA16(__builtin_bit_cast(bf16x8, av), pb[ks], O[mb]); }
        }
        l += __shfl_xor(l, 16); l += __shfl_xor(l, 32); const float inv = 1.0f / l;
#pragma unroll
        for (int mb = 0; mb < 4; ++mb) { u32x2 wv; wv.x = pk2(O[mb][0] * inv, O[mb][1] * inv); wv.y = pk2(O[mb][2] * inv, O[mb][3] * inv); *(u32x2*)(qrow + 16 * mb + 4 * q) = wv; }
        LBAR();
        if (nxt >= 1024) break;
        item = nxt; Qb[0] = Qn[0]; Qb[1] = Qn[1];
    }
#undef ATT_FIRST
}

DI void combine_yd(const Params& P) {
    const bf16_t* OF = (const bf16_t*)(P.ws + WS_OF); const bf16_t* OB = (const bf16_t*)(P.ws + WS_OB); const bf16_t* DZ = (const bf16_t*)(P.ws + WS_DZ); bf16_t* YD = (bf16_t*)(P.ws + WS_YD); const float* g = P.in[14];
    const int stride = gridDim.x * NT; int task = blockIdx.x * NT + threadIdx.x;
    u32x4 ar[2], cr[2], zr[2];
    if (task < 524288) { const size_t off = (size_t)task * 16; ar[0] = *(const u32x4*)(OF + off); ar[1] = *(const u32x4*)(OF + off + 8); cr[0] = *(const u32x4*)(OB + off); cr[1] = *(const u32x4*)(OB + off + 8); zr[0] = *(const u32x4*)(DZ + off); zr[1] = *(const u32x4*)(DZ + off + 8); }
    for (; task < 524288; task += stride) {
        const size_t off = (size_t)task * 16; const int seg = task & 3; float v[16]; float ss = 0.f; u32x4 an[2], cn[2], zn[2];
#pragma unroll
        for (int j = 0; j < 2; ++j) { an[j] = ar[j]; cn[j] = cr[j]; zn[j] = zr[j]; }
        if (task + stride < 524288) { const size_t o2 = (size_t)(task + stride) * 16;
            an[0] = *(const u32x4*)(OF + o2); an[1] = *(const u32x4*)(OF + o2 + 8); cn[0] = *(const u32x4*)(OB + o2); cn[1] = *(const u32x4*)(OB + o2 + 8); zn[0] = *(const u32x4*)(DZ + o2); zn[1] = *(const u32x4*)(DZ + o2 + 8); }
#pragma unroll
        for (int j = 0; j < 2; ++j) { const u32x4 a = ar[j], c = cr[j];
            v[j * 8 + 0] = lo16(a.x) + lo16(c.x); v[j * 8 + 1] = hi16(a.x) + hi16(c.x); v[j * 8 + 2] = lo16(a.y) + lo16(c.y); v[j * 8 + 3] = hi16(a.y) + hi16(c.y);
            v[j * 8 + 4] = lo16(a.z) + lo16(c.z); v[j * 8 + 5] = hi16(a.z) + hi16(c.z); v[j * 8 + 6] = lo16(a.w) + lo16(c.w); v[j * 8 + 7] = hi16(a.w) + hi16(c.w); }
#pragma unroll
        for (int d = 0; d < 16; ++d) ss += v[d] * v[d];
        ss += __shfl_xor(ss, 1); ss += __shfl_xor(ss, 2);
        const float rs = rsqrtf(ss * (1.0f / 64.0f) + 1e-6f);
#pragma unroll
        for (int j = 0; j < 2; ++j) { const u32x4 z = zr[j]; float y[8];
            y[0] = silu(lo16(z.x)); y[1] = silu(hi16(z.x)); y[2] = silu(lo16(z.y)); y[3] = silu(hi16(z.y)); y[4] = silu(lo16(z.z)); y[5] = silu(hi16(z.z)); y[6] = silu(lo16(z.w)); y[7] = silu(hi16(z.w));
#pragma unroll
            for (int e = 0; e < 8; ++e) y[e] *= v[j * 8 + e] * rs * g[seg * 16 + j * 8 + e];
            u32x4 wv; wv.x = pk2(y[0], y[1]); wv.y = pk2(y[2], y[3]); wv.z = pk2(y[4], y[5]); wv.w = pk2(y[6], y[7]); *(u32x4*)(YD + off + j * 8) = wv; }
#pragma unroll
        for (int j = 0; j < 2; ++j) { ar[j] = an[j]; cr[j] = cn[j]; zr[j] = zn[j]; }
    }
}


DI void dadb_stage(const Params& P, unsigned char* smem) {
    const bf16_t* B = (const bf16_t*)(P.ws + WS_WIN) + (size_t)4864 * 1024;
#pragma unroll
    for (int i = 0; i < 8; ++i) { const int p = threadIdx.x + 512 * i, row = p >> 7, c8 = p & 127; *(u32x4*)((bf16_t*)smem + row * 1032 + c8 * 8) = *(const u32x4*)(B + (size_t)row * 1024 + c8 * 8); }
}
DI void dadb_task(const Params& P, int task, int lane, const unsigned char* smem) {
    const int r16 = lane & 15, q = lane >> 4; const bf16_t* A = (const bf16_t*)(P.ws + WS_H) + (size_t)(task * 16 + r16) * 1024 + 8 * q; const bf16_t* B = (const bf16_t*)smem + r16 * 1032 + 8 * q;
    f32x4 acc0 = (f32x4){0.f, 0.f, 0.f, 0.f}, acc1 = acc0; bf16x8 a[32];
#pragma unroll
    for (int ks = 0; ks < 32; ++ks) a[ks] = *(const bf16x8*)(A + 32 * ks);
    __builtin_amdgcn_sched_barrier(0);
#pragma unroll
    for (int ks = 0; ks < 32; ++ks) { acc0 = MFMA16(a[ks], *(const bf16x8*)(B + 32 * ks), acc0); acc1 = MFMA16(a[ks], *(const bf16x8*)(B + 16 * 1032 + 32 * ks), acc1); }
    float* AB = (float*)(P.ws + WS_AB) + (size_t)(task * 16 + 4 * q) * 32 + r16;
#pragma unroll
    for (int i = 0; i < 4; ++i) { AB[i * 32] = acc0[i]; AB[i * 32 + 16] = acc1[i]; }
}

#define XB_TMO      128
#define XB_XCNT(j)  (256  + 64 * (j))
#define XB_XSUB(j)  (1280 + 64 * (j))
#define XB_XGEN(j)  (2304 + 64 * (j))
#define XB_TOP      3328
#define XB_TOPGEN   3392
#define XCD_BAR_WORDS 3456
#define XB_SPIN_CAP (1u << 18)
#define LASB __attribute__((address_space(3)))
DI unsigned xb_ld(unsigned* p)              { return __hip_atomic_load(p, __ATOMIC_RELAXED, __HIP_MEMORY_SCOPE_AGENT); }
DI unsigned xb_add(unsigned* p, unsigned v) { return __hip_atomic_fetch_add(p, v, __ATOMIC_RELAXED, __HIP_MEMORY_SCOPE_AGENT); }
DI unsigned xb_xcc_id() { return (unsigned)__builtin_amdgcn_s_getreg((3 << 11) | 20) & 0xFu; }
#define XB_SPIN(cond, bar) do { unsigned _sp = 0; while (cond) { __builtin_amdgcn_s_sleep(1); \
    if ((++_sp & 255u) == 0u) { if (xb_ld(&(bar)[XB_TMO])) break; if (_sp > XB_SPIN_CAP) { atomicAdd(&(bar)[XB_TMO], 1u); break; } } } } while (0)
struct XcdBarrier { unsigned* bar; unsigned x; volatile LASB unsigned* st; };
DI XcdBarrier xcd_barrier_post(unsigned* bar, volatile LASB unsigned* st) {
    XcdBarrier b; b.bar = bar; b.x = xb_xcc_id(); b.st = st;
    if (threadIdx.x == 0) (void)xb_add(&bar[XB_XCNT(b.x)], 1u);
    return b;
}
DI void xcd_barrier_complete(unsigned* bar, unsigned x, unsigned& nloc, unsigned& nx) {
    const unsigned G = gridDim.x * gridDim.y * gridDim.z;
    unsigned sum, cnt, mine, sp = 0u;
    for (;;) {
        sum = 0u; cnt = 0u; mine = 0u;
#pragma unroll
        for (unsigned j = 0; j < 16; ++j) { const unsigned c = xb_ld(&bar[XB_XCNT(j)]); sum += c; cnt += (c > 0u) ? 1u : 0u; mine = (j == x) ? c : mine; }
        if (sum == G) break;
        __builtin_amdgcn_s_sleep(1);
        if ((++sp & 255u) == 0u) { if (xb_ld(&bar[XB_TMO])) break; if (sp > XB_SPIN_CAP) { atomicAdd(&bar[XB_TMO], 1u); break; } }
    }
    nloc = mine > 0u ? mine : 1u; nx = cnt > 0u ? cnt : 1u;
}
DI void xcd_barrier(const XcdBarrier& b) {
    asm volatile("s_waitcnt vmcnt(0)" ::: "memory");
    __syncthreads();
    if (threadIdx.x == 0) {
        unsigned* bar = b.bar;
        __builtin_amdgcn_s_waitcnt(0);
        unsigned nloc = b.st[0], nx = b.st[1];
        if (nloc == 0u) { xcd_barrier_complete(bar, b.x, nloc, nx); b.st[0] = nloc; b.st[1] = nx; }
        const unsigned old = xb_add(&bar[XB_XSUB(b.x)], 1u);
        const unsigned gen = old / nloc;
        if (old + 1u == (gen + 1u) * nloc) {
            __builtin_amdgcn_fence(__ATOMIC_RELEASE, "agent");
            asm volatile("s_waitcnt vmcnt(0)" ::: "memory");
            const unsigned og = xb_add(&bar[XB_TOP], 1u);
            const unsigned tg = og / nx;
            if (og + 1u == (tg + 1u) * nx) xb_add(&bar[XB_TOPGEN], 1u);
            else XB_SPIN(xb_ld(&bar[XB_TOPGEN]) == tg, bar);
            __builtin_amdgcn_fence(__ATOMIC_ACQUIRE, "agent");
            xb_add(&bar[XB_XGEN(b.x)], 1u);
            asm volatile("s_waitcnt vmcnt(0)" ::: "memory");
        } else {
            XB_SPIN(xb_ld(&bar[XB_XGEN(b.x)]) == gen, bar);
            __builtin_amdgcn_fence(__ATOMIC_ACQUIRE, "agent");
            asm volatile("s_waitcnt vmcnt(0)" ::: "memory");
        }
    }
    __syncthreads();
}

__global__ void __launch_bounds__(NT) fwd(Params P) {
    extern __shared__ __attribute__((aligned(16))) unsigned char lds[];
    cg::grid_group grid = cg::this_grid();
    const int tid = threadIdx.x, bid = blockIdx.x, G = gridDim.x;
    unsigned char* ws = P.ws;
    volatile int* sItem = (volatile int*)(lds + 131072);
    if (tid < 8) ((volatile LASB unsigned*)(lds + 131072 + 16))[tid] = 0u;
    __syncthreads();
    XcdBarrier xbar = xcd_barrier_post((unsigned*)(ws + 4096), (volatile LASB unsigned*)(lds + 131072 + 16));
    if (P.ws == nullptr) grid.sync();
#define GRID_SYNC() xcd_barrier(xbar)
    pg8::EpiP ep; ep.AQ = (bf16_t*)(ws + WS_AQ); ep.AKV = (bf16_t*)(ws + WS_AKV); ep.DQKV = (bf16_t*)(ws + WS_DQKV); ep.DZ = (bf16_t*)(ws + WS_DZ); ep.GATES = (bf16_t*)P.out; ep.Y = (bf16_t*)(ws + WS_Y);
    ep.AB = (float*)(ws + WS_AB); ep.x = P.in[0]; ep.mod = (const float*)(ws + WS_MOD); ep.out = P.out; ep.ACT = (bf16_t*)(ws + WS_ACT); ep.g2 = P.in[18]; ep.H2 = (bf16_t*)(ws + WS_H2); ep.rowsq = (float*)(ws + WS_ROWSQ); ep.bias = (const float*)(ws + WS_BIAS);
    PG8_LAS unsigned char* glds = (PG8_LAS unsigned char*)lds;

#ifdef PROBE_SYNC
    for (int i = 0; i < PROBE_SYNC; ++i) GRID_SYNC();
#endif
    { float* tile = (float*)lds;
#ifndef NO_P0
      for (int it = bid; it < 768; it += G) mod_item(P, it, tile);
#define DEC_WIN(t) dec_win(P, (t))
      __syncthreads(); CONV_TILES(bid, G, 624, DEC_WIN, tile, NO_HOOK);
      const int gt = bid * NT + tid; if (gt < 1024) { const int pos = gt >> 4, f = gt & 15; const float ang = (float)pos * powf(10000.0f, -(float)f / 16.0f); float* TAB = (float*)(ws + WS_TAB); TAB[2 * gt] = cosf(ang); TAB[2 * gt + 1] = sinf(ang); }
#endif
    }
    GRID_SYNC();
#ifndef NO_P1
#ifdef PROBE_P1
    for (int rep = 0; rep < PROBE_P1; ++rep)
#endif
    modnorm_rows(P.in[0], P.in[2], 18432, P.in[6], (const float*)(ws + WS_MOD), 0, 1024, (bf16_t*)(ws + WS_H));
#endif
    GRID_SYNC();
#ifndef NO_P2
#ifdef PROBE_G1
    for (int rep = 0; rep < PROBE_G1; ++rep)
#endif
    { pg8::Gemm g{(const bf16_t*)(ws + WS_H), (const bf16_t*)(ws + WS_WIN), 18432, 4864, 1024}; pg8::SchedIn S{G, bid}; pg8::Epi<0> E{ep}; pg8::gemm_phase<pg8::Epi<0>, pg8::SchedIn, GEMM_ALIGN, GEMM_SP2>(glds, g, S, E); }
    { dadb_stage(P, lds); __syncthreads();
    for (int task = (tid >> 6) * G + bid; task < 1152; task += G * 8) dadb_task(P, task, tid & 63, lds); }
#endif
    GRID_SYNC();
#ifndef NO_P4A
#ifdef PROBE_PREP
    for (int rep = 0; rep < PROBE_PREP; ++rep)
#endif
    prep_phase(P, lds);
#endif
#ifndef NO_P4B
    qk_normrope(P);
#endif
    GRID_SYNC();
#ifndef NO_P5A
#ifdef PROBE_SCAN
    for (int rep = 0; rep < PROBE_SCAN; ++rep)
#endif
    if (bid < 128) scan_block(P, bid, lds);
#endif
#ifndef NO_P5B
    attn_phase(P, lds, (unsigned*)(ws + WS_CTL), sItem);
#endif
    GRID_SYNC();
#ifndef NO_P6
#ifdef PROBE_EW
    for (int rep = 0; rep < PROBE_EW; ++rep) {
#else
    {
#endif
    combine_yd(P);
    { float* tile = (float*)lds;
#define DEC_REST(t) dec_rest(P, (t))
      __syncthreads(); CONV_TILES(bid, G, 1280, DEC_REST, tile, BIAS_HOOK); }
    }
#endif
    GRID_SYNC();
#ifndef NO_P7
#ifdef PROBE_G23
    for (int rep = 0; rep < PROBE_G23; ++rep)
#endif
    { pg8::Gemm g{(const bf16_t*)(ws + WS_AQ), (const bf16_t*)(ws + WS_WBR), 16384, 1024, 512, 16, 8, (size_t)16 * MiB - 1024, (size_t)1024 * 512 * 2 - 1024}; pg8::SchedStd S{4, 256, G, bid}; pg8::Epi<1> E{ep}; pg8::gemm_phase<pg8::Epi<1>, pg8::SchedStd, GEMM_ALIGN, GEMM_SP2>(glds, g, S, E); }
#endif
    GRID_SYNC();
#ifndef NO_P8
#ifdef PROBE_G23
    for (int rep = 0; rep < PROBE_G23; ++rep)
#endif
    { pg8::Gemm g{(const bf16_t*)(ws + WS_Y), (const bf16_t*)(ws + WS_WOUT), 16384, 1024, 1024}; pg8::SchedStd S{4, 256, G, bid}; pg8::Epi<2> E{ep}; pg8::gemm_phase<pg8::Epi<2>, pg8::SchedStd, GEMM_ALIGN, GEMM_SP2>(glds, g, S, E); }
#endif
    GRID_SYNC();
#ifndef NO_P10
#ifdef PROBE_G4
    for (int rep = 0; rep < PROBE_G4; ++rep)
#endif
    { pg8::Gemm g{(const bf16_t*)(ws + WS_H2), (const bf16_t*)(ws + WS_WM1), 16384, 4096, 1024}; pg8::SchedStd S{16, 1024, G, bid}; pg8::Epi<3> E{ep}; pg8::gemm_phase<pg8::Epi<3>, pg8::SchedStd, GEMM_ALIGN, GEMM_SP2>(glds, g, S, E); }
#endif
    GRID_SYNC();
#ifndef NO_P11
    { pg8::Gemm g{(const bf16_t*)(ws + WS_ACT), (const bf16_t*)(ws + WS_WM2), 16384, 1024, 4096}; pg8::SchedStd S{4, 256, G, bid}; pg8::Epi<4> E{ep}; pg8::gemm_phase<pg8::Epi<4>, pg8::SchedStd, GEMM_ALIGN, GEMM_SP2>(glds, g, S, E); }
#endif
}
}

extern "C" void kernel_launch(void* const* d_in, const int* in_sizes, int n_in, void* d_out, int out_size, void* d_ws, size_t ws_size, hipStream_t stream) {
    static int grid = 0;
    if (grid == 0) {
        if (n_in != 21 || ws_size < mk::WS_END) { fprintf(stderr, "kernel_launch: unexpected inputs (n_in %d, ws %zu)\n", n_in, ws_size); grid = -1; return; }
        int dev = 0, cus = 0, per_cu = 0;
        hipGetDevice(&dev); hipDeviceGetAttribute(&cus, hipDeviceAttributeMultiprocessorCount, dev);
        if (hipFuncSetAttribute((const void*)mk::fwd, hipFuncAttributeMaxDynamicSharedMemorySize, mk::LDS_BYTES) != hipSuccess) { fprintf(stderr, "kernel_launch: hipFuncSetAttribute failed\n"); grid = -1; return; }
        if (hipOccupancyMaxActiveBlocksPerMultiprocessor(&per_cu, (const void*)mk::fwd, mk::NT, mk::LDS_BYTES) != hipSuccess || per_cu < 1) { fprintf(stderr, "kernel_launch: occupancy query says %d\n", per_cu); per_cu = 1; }
        (void)hipGetLastError();
        grid = cus * 1;
        if (grid % 8 != 0 || grid < 64) { fprintf(stderr, "kernel_launch: unexpected CU count %d\n", cus); }
    }
    if (grid < 0) return;
    hipMemsetAsync((char*)d_ws + mk::WS_CTL, 0, 512 * 1024, stream);
    mk::Params p{};
    for (int i = 0; i < 21; ++i) p.in[i] = (const float*)d_in[i];
    p.out = (float*)d_out; p.ws = (unsigned char*)d_ws;
    void* args[] = {&p};
    hipError_t e = hipLaunchCooperativeKernel((const void*)mk::fwd, dim3(grid), dim3(mk::NT), args, mk::LDS_BYTES, stream);
    if (e != hipSuccess) fprintf(stderr, "cooperative launch failed: %s (grid %d)\n", hipGetErrorString(e), grid);
}
```

```cpp
#include <hip/hip_runtime.h>
#include <hip/hip_cooperative_groups.h>
#include <cstdio>
#include <cstdint>
namespace cg = cooperative_groups;

namespace pg8 {
#define PG8_LAS __attribute__((address_space(3)))
typedef unsigned short bf16_t;
typedef short bf16x8 __attribute__((ext_vector_type(8)));
typedef float f32x4 __attribute__((ext_vector_type(4)));
typedef unsigned u32x4 __attribute__((ext_vector_type(4)));
constexpr int BM = 256, BK = 64, HALF = 128, HTB = HALF * BK * 2  , STAGE_BYTES = 8 * HTB, NXCD = 8, WGM = 8;

__host__ __device__ __forceinline__ int lds_byte(int r, int c) { const int st = (r >> 4) * 2 + (c >> 5), rr = r & 15, cc = c & 31, ob = rr * 64 + cc * 2; return st * 1024 + (ob ^ (((ob >> 9) & 1) << 5)); }
__host__ __device__ __forceinline__ void stage_rc(int b, int& R, int& C) { const int st = b / 1024, sb = b % 1024, swz = sb ^ (((sb >> 9) & 1) << 5); R = (st >> 1) * 16 + swz / 64; C = (st & 1) * 32 + (swz % 64) / 2; }
__host__ __device__ __forceinline__ int perm32(int rho) { const int n = rho >> 4, i = rho & 15; return 8 * (i >> 2) + 4 * n + (i & 3); }

struct Unit { int pm, pn; };
struct Gemm { const bf16_t* A; const bf16_t* Bt; int M, N, K; int nt = 0, jt = 0; size_t ja = 0, jb = 0; };


typedef unsigned u32x2 __attribute__((ext_vector_type(2)));
typedef short s16x4 __attribute__((ext_vector_type(4)));
__device__ __forceinline__ unsigned pk2(float a, float b) { typedef __bf16 bv2 __attribute__((ext_vector_type(2))); bv2 v; v[0] = (__bf16)a; v[1] = (__bf16)b; return __builtin_bit_cast(unsigned, v); }
__device__ __forceinline__ float lo16(unsigned u) { return __uint_as_float(u << 16); }
__device__ __forceinline__ float hi16(unsigned u) { return __uint_as_float(u & 0xffff0000u); }
__device__ __forceinline__ float bf2f(bf16_t v) { return __uint_as_float(((unsigned)v) << 16); }

__device__ __forceinline__ void map_static(int L, int nwg, int nN, int& pm, int& pn) {
    const int q = nwg / NXCD, xcd = L % NXCD, off = L / NXCD, wgid = xcd * q + off;
    const int nig = WGM * nN, gid = wgid / nig; pm = gid * WGM + ((wgid % nig) % WGM); pn = (wgid % nig) / WGM;
}
struct SchedStd {
    int nN, nwg, G, c;
    __device__ __forceinline__ bool next(int i, Unit& u) const { const long L = (long)i * G + c; if (L >= nwg) return false; map_static((int)L, nwg, nN, u.pm, u.pn); return true; }
    __device__ __forceinline__ void a_ready(const Unit&) const {}
    __device__ __forceinline__ void done(const Unit&) const {}
};
struct SchedIn {
    int G, c;
    __device__ __forceinline__ bool next(int i, Unit& u) const {
        const long L = (long)i * G + c; if (L >= 1256) return false;
        if (L < 1216) map_static((int)L, 1216, 19, u.pm, u.pn);
        else { const int Lc = (int)L - 1216, t = Lc >> 3; u.pm = 64 + (Lc & 7); u.pn = t == 0 ? 2 : t + 4; }
        return true;
    }
    __device__ __forceinline__ void a_ready(const Unit&) const {}
    __device__ __forceinline__ void done(const Unit&) const {}
};
struct SchedBr {
    int G, c;
    __device__ __forceinline__ bool next(int i, Unit& u) const {
        const long L = (long)(i >> 1) * G + c; if (L >= 256) return false; const int br = i & 1; int pm, pn; map_static((int)L, 256, 4, pm, pn);
        u.pm = pm + 64 * br; u.pn = pn + 4 * br; return true;
    }
    __device__ __forceinline__ void a_ready(const Unit&) const {}
    __device__ __forceinline__ void done(const Unit&) const {}
};

struct EpiP { bf16_t* AQ; bf16_t* AKV; bf16_t* DQKV; bf16_t* DZ; bf16_t* GATES; bf16_t* Y; float* AB; const float* x; const float* mod; float* out; bf16_t* ACT; const float* g2; bf16_t* H2; float* rowsq; const float* bias; };
template <int MODE> struct Epi {
    static constexpr bool PERM = true, AFTER_DRAIN = false, HAS_MID = (MODE == 1);
    EpiP p;
    __device__ __forceinline__ void operator()(const f32x4 (&acc)[2][2][4][2], const Unit& u, int wr, int wc, int fr, int fq) const {
        if (MODE == 0) {
            const int pn = u.pn; const int row0 = u.pm * BM + wr * 64 + fr;
            if (pn >= 11) {
                const int colg = (pn - 11) * 128 + wc * 32 + 8 * fq;
#pragma unroll
                for (int ai = 0; ai < 2; ++ai)
#pragma unroll
                    for (int m = 0; m < 4; ++m) { bf16_t* rp = p.GATES + (size_t)(row0 + ai * HALF + m * 16) * 2048 + colg; f32x4 rr[2], sd[2];
#pragma unroll
                        for (int n = 0; n < 2; ++n)
#pragma unroll
                            for (int j = 0; j < 4; ++j) { const float ga = fminf(fmaxf(acc[ai][0][m][n][j], -30.f), 30.f), gd = fminf(fmaxf(acc[ai][1][m][n][j], -30.f), 30.f);
                                const float ea = 1.0f + __expf(-ga), ed = 1.0f + __expf(-gd), ia = __builtin_amdgcn_rcpf(ea); rr[n][j] = ed * ia; sd[n][j] = __builtin_amdgcn_rcpf(ed); }
                        u32x4 w; w.x = pk2(rr[0][0], rr[0][1]); w.y = pk2(rr[0][2], rr[0][3]); w.z = pk2(rr[1][0], rr[1][1]); w.w = pk2(rr[1][2], rr[1][3]); *(u32x4*)rp = w;
                        w.x = pk2(sd[0][0], sd[0][1]); w.y = pk2(sd[0][2], sd[0][3]); w.z = pk2(sd[1][0], sd[1][1]); w.w = pk2(sd[1][2], sd[1][3]); *(u32x4*)(rp + 1024) = w; }
                return;
            }
            bf16_t* base; int ld, cofs;
            if (pn < 2) { base = p.AQ; ld = 512; cofs = 0; } else if (pn == 2) { base = p.AKV; ld = 256; cofs = 512; } else if (pn < 9) { base = p.DQKV; ld = 1536; cofs = 768; }
            else { base = p.DZ; ld = 512; cofs = 2304; }
            const int colt = pn * BM - cofs + wc * 32 + 8 * fq;
#pragma unroll
            for (int ai = 0; ai < 2; ++ai)
#pragma unroll
                for (int m = 0; m < 4; ++m) { bf16_t* rp = base + (size_t)(row0 + ai * HALF + m * 16) * ld + colt;
#pragma unroll
                    for (int bj = 0; bj < 2; ++bj) { const f32x4 v0 = acc[ai][bj][m][0], v1 = acc[ai][bj][m][1];
                        u32x4 w; w.x = pk2(v0[0], v0[1]); w.y = pk2(v0[2], v0[3]); w.z = pk2(v1[0], v1[1]); w.w = pk2(v1[2], v1[3]); *(u32x4*)(rp + bj * HALF) = w; } }
        } else if (MODE == 1) {
            const int row0 = u.pm * BM + wr * 64 + fr, col0 = u.pn * BM + wc * 32 + 8 * fq;
#pragma unroll
            for (int ai = 0; ai < 2; ++ai) { u32x4 g[4][2];
#pragma unroll
                for (int m = 0; m < 4; ++m)
#pragma unroll
                    for (int bj = 0; bj < 2; ++bj) g[m][bj] = *(const u32x4*)(p.GATES + (size_t)(row0 + ai * HALF + m * 16) * 2048 + 1024 + col0 + bj * HALF);
#pragma unroll
                for (int m = 0; m < 4; ++m) { bf16_t* yp = p.Y + (size_t)(row0 + ai * HALF + m * 16) * 1024 + col0;
#pragma unroll
                    for (int bj = 0; bj < 2; ++bj) { const f32x4 a0 = acc[ai][bj][m][0], a1 = acc[ai][bj][m][1]; const u32x4 gg = g[m][bj];
                        u32x4 w; w.x = pk2(lo16(gg.x) * a0[0], hi16(gg.x) * a0[1]); w.y = pk2(lo16(gg.y) * a0[2], hi16(gg.y) * a0[3]); w.z = pk2(lo16(gg.z) * a1[0], hi16(gg.z) * a1[1]); w.w = pk2(lo16(gg.w) * a1[2], hi16(gg.w) * a1[3]);
                        *(u32x4*)(yp + bj * HALF) = w; } } }
        } else if (MODE == 2) {
            const int row0 = u.pm * BM + wr * 64 + fr, col0 = u.pn * BM + wc * 32 + 8 * fq; const float* mb = p.mod + (size_t)(u.pm >> 3) * 6144 + col0;
            f32x4 gv[2][2], hv[2][2];
#pragma unroll
            for (int bj = 0; bj < 2; ++bj)
#pragma unroll
                for (int n = 0; n < 2; ++n) { gv[bj][n] = *(const f32x4*)(mb + 2048 + bj * HALF + n * 4); hv[bj][n] = *(const f32x4*)(p.g2 + col0 + bj * HALF + n * 4) * (*(const f32x4*)(mb + 4096 + bj * HALF + n * 4) + 1.0f); }
#pragma unroll
            for (int ai = 0; ai < 2; ++ai)
#pragma unroll
                for (int mh = 0; mh < 2; ++mh) { f32x4 xb[2][2][2];
#pragma unroll
                    for (int mm = 0; mm < 2; ++mm)
#pragma unroll
                        for (int bj = 0; bj < 2; ++bj)
#pragma unroll
                            for (int n = 0; n < 2; ++n) xb[mm][bj][n] = *(const f32x4*)(p.x + (size_t)(row0 + ai * HALF + (2 * mh + mm) * 16) * 1024 + col0 + bj * HALF + n * 4);
#pragma unroll
                    for (int mm = 0; mm < 2; ++mm) { const int m = 2 * mh + mm; const int row = row0 + ai * HALF + m * 16; const size_t off = (size_t)row * 1024 + col0; float ss = 0.f;
#pragma unroll
                        for (int bj = 0; bj < 2; ++bj) { f32x4 a2[2];
#pragma unroll
                            for (int n = 0; n < 2; ++n) { const f32x4 x1 = xb[mm][bj][n] + gv[bj][n] * acc[ai][bj][m][n];
                                *(f32x4*)(p.out + off + bj * HALF + n * 4) = x1; ss += x1[0] * x1[0] + x1[1] * x1[1] + x1[2] * x1[2] + x1[3] * x1[3]; a2[n] = x1 * hv[bj][n]; }
                            u32x4 w; w.x = pk2(a2[0][0], a2[0][1]); w.y = pk2(a2[0][2], a2[0][3]); w.z = pk2(a2[1][0], a2[1][1]); w.w = pk2(a2[1][2], a2[1][3]); *(u32x4*)(p.H2 + off + bj * HALF) = w; }
                        ss += __shfl_xor(ss, 16); ss += __shfl_xor(ss, 32); if (fq == 0) atomicAdd(p.rowsq + row, ss); } }
        } else if (MODE == 4) {
            const int row0 = u.pm * BM + wr * 64 + fr, col0 = u.pn * BM + wc * 32 + 8 * fq; const float* gt = p.mod + (size_t)(u.pm >> 3) * 6144 + 5120 + col0;
            f32x4 gv[2][2];
#pragma unroll
            for (int bj = 0; bj < 2; ++bj)
#pragma unroll
                for (int n = 0; n < 2; ++n) gv[bj][n] = *(const f32x4*)(gt + bj * HALF + n * 4);
#pragma unroll
            for (int ai = 0; ai < 2; ++ai) { f32x4 ob[4][2][2];
#pragma unroll
                for (int m = 0; m < 4; ++m)
#pragma unroll
                    for (int bj = 0; bj < 2; ++bj)
#pragma unroll
                        for (int n = 0; n < 2; ++n) ob[m][bj][n] = *(const f32x4*)(p.out + (size_t)(row0 + ai * HALF + m * 16) * 1024 + col0 + bj * HALF + n * 4);
#pragma unroll
                for (int m = 0; m < 4; ++m) { const size_t off = (size_t)(row0 + ai * HALF + m * 16) * 1024 + col0;
#pragma unroll
                    for (int bj = 0; bj < 2; ++bj)
#pragma unroll
                        for (int n = 0; n < 2; ++n) *(f32x4*)(p.out + off + bj * HALF + n * 4) = ob[m][bj][n] + gv[bj][n] * acc[ai][bj][m][n]; } }
        } else {
            const int row0 = u.pm * BM + wr * 64 + fr, col0 = u.pn * BM + wc * 32 + 8 * fq; const float* bp = p.bias + (size_t)(u.pm >> 3) * 4096 + col0;
            f32x4 bv[2][2];
#pragma unroll
            for (int bj = 0; bj < 2; ++bj)
#pragma unroll
                for (int n = 0; n < 2; ++n) bv[bj][n] = *(const f32x4*)(bp + bj * HALF + n * 4);
            float rq[2][4];
#pragma unroll
            for (int ai = 0; ai < 2; ++ai)
#pragma unroll
                for (int m = 0; m < 4; ++m) rq[ai][m] = p.rowsq[row0 + ai * HALF + m * 16];
#pragma unroll
            for (int ai = 0; ai < 2; ++ai)
#pragma unroll
                for (int m = 0; m < 4; ++m) { const int row = row0 + ai * HALF + m * 16; bf16_t* rp = p.ACT + (size_t)row * 4096 + col0; const float rstd = rsqrtf(rq[ai][m] * (1.0f / 1024.0f) + 1e-6f);
#pragma unroll
                    for (int bj = 0; bj < 2; ++bj) { f32x4 v0 = acc[ai][bj][m][0] * rstd + bv[bj][0], v1 = acc[ai][bj][m][1] * rstd + bv[bj][1];
#pragma unroll
                        for (int j = 0; j < 4; ++j) { const float t0 = fmaxf(v0[j], 0.f), t1 = fmaxf(v1[j], 0.f); v0[j] = t0 * t0; v1[j] = t1 * t1; }
                        u32x4 w; w.x = pk2(v0[0], v0[1]); w.y = pk2(v0[2], v0[3]); w.z = pk2(v1[0], v1[1]); w.w = pk2(v1[2], v1[3]); *(u32x4*)(rp + bj * HALF) = w; } }
        }
    }
    __device__ __forceinline__ void mid(f32x4 (&acc)[2][2][4][2], const Unit& u, int wr, int wc, int fr, int fq) const {
        const int row0 = u.pm * BM + wr * 64 + fr, col0 = u.pn * BM + wc * 32 + 8 * fq;
        const bf16_t* gp = p.GATES + (size_t)row0 * 2048 + col0;
#pragma unroll
        for (int ai = 0; ai < 2; ++ai)
#pragma unroll
            for (int m = 0; m < 4; ++m) { asm volatile("" : "+v"(gp));
#pragma unroll
                for (int bj = 0; bj < 2; ++bj) { const u32x4 g = *(const u32x4*)(gp + bj * HALF);
                    acc[ai][bj][m][0][0] *= lo16(g.x); acc[ai][bj][m][0][1] *= hi16(g.x); acc[ai][bj][m][0][2] *= lo16(g.y); acc[ai][bj][m][0][3] *= hi16(g.y);
                    acc[ai][bj][m][1][0] *= lo16(g.z); acc[ai][bj][m][1][1] *= hi16(g.z); acc[ai][bj][m][1][2] *= lo16(g.w); acc[ai][bj][m][1][3] *= hi16(g.w); }
                gp += (m == 3 ? (HALF - 48) : 16) * 2048;
                if (m == 1 || m == 3) asm volatile("" ::: "memory"); }
    }
};

template <class Epi, class Sched, bool ALIGN_EPI = false, bool SP2 = false>
__device__ __forceinline__ void gemm_phase(PG8_LAS unsigned char* lds, const Gemm g, const Sched& S, const Epi& E) {
    int tid_ = threadIdx.x; asm volatile("" : "+v"(tid_)); const int tid = tid_, wid = __builtin_amdgcn_readfirstlane(tid >> 6), lane = tid & 63, wr = wid >> 2, wc = wid & 3, fr = lane & 15, fq = lane >> 4;
    const int K = g.K, nt = g.nt ? g.nt : K / BK;
    unsigned voffA[2], voffB[2];
#pragma unroll
    for (int i = 0; i < 2; ++i) { int R, C; stage_rc(tid * 16 + i * 8192, R, C); const int Rb = Epi::PERM ? ((R & ~31) + perm32(R & 31)) : R;
        voffA[i] = (unsigned)(R * K + C) * 2u; voffB[i] = (unsigned)(Rb * K + C) * 2u; }
    const size_t kstep = (size_t)(BK * 2);
    const size_t hstep = (size_t)HALF * K * 2;
    const size_t tstep = 2 * hstep;
    const unsigned ldsw = (unsigned)wid * 1024u;
    const int aoff = lds_byte(wr * 64 + fr, fq * 8), boff = lds_byte(wc * 32 + fr, fq * 8);
#define PG8_SA(b, h) (((b) * 2 + (h)) * HTB)
#define PG8_SB(b, h) ((4 + (b) * 2 + (h)) * HTB)
#define PG8_STAGE(bufoff, gbase, voff) do { _Pragma("unroll") for (int _i = 0; _i < 2; ++_i) \
        __builtin_amdgcn_global_load_lds((const unsigned*)((const char*)(gbase) + (voff)[_i]), (PG8_LAS unsigned*)(lds + (bufoff) + ldsw + _i * 8192), 16, 0, 0); } while (0)
#define PG8_LDA(dst, b, h) do { _Pragma("unroll") for (int m = 0; m < 4; ++m) _Pragma("unroll") for (int k = 0; k < 2; ++k) dst[m][k] = *(const PG8_LAS bf16x8*)(lds + PG8_SA(b, h) + aoff + m * 2048 + k * 1024); } while (0)
#define PG8_LDB(dst, b, h) do { _Pragma("unroll") for (int n = 0; n < 2; ++n) _Pragma("unroll") for (int k = 0; k < 2; ++k) dst[n][k] = *(const PG8_LAS bf16x8*)(lds + PG8_SB(b, h) + boff + n * 2048 + k * 1024); } while (0)
#define PG8_MMA(ai, bj, At, Bt) do { __builtin_amdgcn_s_setprio(1); _Pragma("unroll") for (int m = 0; m < 4; ++m) _Pragma("unroll") for (int n = 0; n < 2; ++n) _Pragma("unroll") for (int k = 0; k < 2; ++k) \
        acc[ai][bj][m][n] = __builtin_amdgcn_mfma_f32_16x16x32_bf16(Bt[n][k], At[m][k], acc[ai][bj][m][n], 0, 0, 0); __builtin_amdgcn_s_setprio(0); } while (0)
#define PG8_WAIT_V(n) asm volatile("s_waitcnt vmcnt(" #n ")" ::: "memory")
#define PG8_WAIT_L(n) asm volatile("s_waitcnt lgkmcnt(" #n ")" ::: "memory")
#define PG8_BAR __builtin_amdgcn_s_barrier()
#define PG8_SCHED __builtin_amdgcn_sched_barrier(0)
    Unit cur, nxt; int ui = 0;
    if (!S.next(0, cur)) return;
    f32x4 acc[2][2][4][2];
#pragma unroll
    for (int a = 0; a < 2; ++a)
#pragma unroll
        for (int b = 0; b < 2; ++b)
#pragma unroll
            for (int m = 0; m < 4; ++m)
#pragma unroll
                for (int n = 0; n < 2; ++n) acc[a][b][m][n] = (f32x4){0.f, 0.f, 0.f, 0.f};
    bf16x8 At[4][2], B0[2][2], B1[2][2];
    const char* cA = (const char*)g.A + (size_t)cur.pm * tstep; const char* cB = (const char*)g.Bt + (size_t)cur.pn * tstep;
    S.a_ready(cur);
    if constexpr (SP2) {
        PG8_STAGE(PG8_SB(0, 0), cB, voffB); PG8_STAGE(PG8_SB(0, 1), cB + hstep, voffB); PG8_STAGE(PG8_SA(0, 0), cA, voffA); PG8_STAGE(PG8_SA(0, 1), cA + hstep, voffA);
        if (wr == 1) PG8_BAR;
        PG8_WAIT_V(2); PG8_BAR;
        PG8_STAGE(PG8_SB(1, 0), cB + kstep, voffB); PG8_STAGE(PG8_SA(1, 0), cA + kstep, voffA); PG8_STAGE(PG8_SB(1, 1), cB + hstep + kstep, voffB);
        PG8_WAIT_V(6); PG8_BAR;
    } else {
        PG8_STAGE(PG8_SB(0, 0), cB, voffB); PG8_STAGE(PG8_SA(0, 0), cA, voffA); PG8_STAGE(PG8_SB(0, 1), cB + hstep, voffB); PG8_STAGE(PG8_SA(0, 1), cA + hstep, voffA);
        if (wr == 1) PG8_BAR;
        PG8_WAIT_V(4); PG8_BAR;
        PG8_STAGE(PG8_SB(1, 0), cB + kstep, voffB); PG8_STAGE(PG8_SA(1, 0), cA + kstep, voffA); PG8_STAGE(PG8_SB(1, 1), cB + hstep + kstep, voffB);
        PG8_WAIT_V(6); PG8_BAR;
    }
    for (;;) {
        const bool has_next = S.next(ui + 1, nxt);
        const char* nA = has_next ? (const char*)g.A + (size_t)nxt.pm * tstep : cA; const char* nB = has_next ? (const char*)g.Bt + (size_t)nxt.pn * tstep : cB;
        for (int t = 0; t < nt; t += 2) {
            const bool last = (t == nt - 2);
            const size_t j1a = (g.jt && t + 1 >= g.jt) ? g.ja : 0, j2a = (g.jt && t + 2 >= g.jt) ? g.ja : 0, j2b = (g.jt && t + 2 >= g.jt) ? g.jb : 0;
            const char* a1 = cA + (size_t)(t + 1) * kstep + j1a;
            const char* a2 = last ? nA : cA + (size_t)(t + 2) * kstep + j2a; const char* b2 = last ? nB : cB + (size_t)(t + 2) * kstep + j2b;
            if constexpr (Epi::HAS_MID) { if (g.jt && t == g.jt) E.mid(acc, cur, wr, wc, fr, fq); }
            const char* a3 = a2 + kstep; const char* b3 = b2 + kstep;
            if (last && has_next) S.a_ready(nxt);
            if constexpr (SP2) {
            PG8_LDB(B0, 0, 0); PG8_LDB(B1, 0, 1); PG8_SCHED; PG8_LDA(At, 0, 0); PG8_STAGE(PG8_SA(1, 1), a1 + hstep, voffA);
            PG8_WAIT_V(8); PG8_WAIT_L(0); PG8_BAR; PG8_MMA(0, 0, At, B0); PG8_MMA(0, 1, At, B1); PG8_BAR; PG8_SCHED;
            PG8_LDA(At, 0, 1); PG8_STAGE(PG8_SB(0, 0), b2, voffB); PG8_STAGE(PG8_SB(0, 1), b2 + hstep, voffB); PG8_STAGE(PG8_SA(0, 0), a2, voffA);
            PG8_WAIT_V(8); PG8_WAIT_L(0); PG8_BAR; PG8_MMA(1, 0, At, B0); PG8_MMA(1, 1, At, B1); PG8_BAR; PG8_SCHED;
            PG8_LDB(B0, 1, 0); PG8_LDB(B1, 1, 1); PG8_SCHED; PG8_LDA(At, 1, 0); PG8_STAGE(PG8_SA(0, 1), a2 + hstep, voffA);
            PG8_WAIT_V(8); PG8_WAIT_L(0); PG8_BAR; PG8_MMA(0, 0, At, B0); PG8_MMA(0, 1, At, B1); PG8_BAR; PG8_SCHED;
            PG8_LDA(At, 1, 1); PG8_STAGE(PG8_SB(1, 0), b3, voffB); PG8_STAGE(PG8_SB(1, 1), b3 + hstep, voffB); PG8_STAGE(PG8_SA(1, 0), a3, voffA);
            PG8_WAIT_V(8); PG8_WAIT_L(0); PG8_BAR; PG8_MMA(1, 0, At, B0); PG8_MMA(1, 1, At, B1); PG8_BAR; PG8_SCHED;
            } else {
            PG8_LDB(B0, 0, 0); PG8_SCHED; PG8_LDA(At, 0, 0); PG8_STAGE(PG8_SA(1, 1), a1 + hstep, voffA);
            PG8_WAIT_L(8); PG8_BAR; PG8_WAIT_L(0); PG8_MMA(0, 0, At, B0); PG8_BAR; PG8_SCHED;
            PG8_LDB(B1, 0, 1); PG8_STAGE(PG8_SB(0, 0), b2, voffB);
            PG8_BAR; PG8_WAIT_L(0); PG8_MMA(0, 1, At, B1); PG8_BAR;
            PG8_LDA(At, 0, 1); PG8_STAGE(PG8_SA(0, 0), a2, voffA);
            PG8_BAR; PG8_WAIT_L(0); PG8_MMA(1, 0, At, B0); PG8_BAR; PG8_SCHED;
            PG8_STAGE(PG8_SB(0, 1), b2 + hstep, voffB);
            PG8_WAIT_V(6); PG8_BAR; PG8_MMA(1, 1, At, B1); PG8_BAR;
            PG8_LDB(B0, 1, 0); PG8_SCHED; PG8_LDA(At, 1, 0); PG8_STAGE(PG8_SA(0, 1), a2 + hstep, voffA);
            PG8_WAIT_L(8); PG8_BAR; PG8_WAIT_L(0); PG8_MMA(0, 0, At, B0); PG8_BAR; PG8_SCHED;
            PG8_LDB(B1, 1, 1); PG8_STAGE(PG8_SB(1, 0), b3, voffB);
            PG8_BAR; PG8_WAIT_L(0); PG8_MMA(0, 1, At, B1); PG8_BAR;
            PG8_LDA(At, 1, 1); PG8_STAGE(PG8_SA(1, 0), a3, voffA);
            PG8_BAR; PG8_WAIT_L(0); PG8_MMA(1, 0, At, B0); PG8_BAR; PG8_SCHED;
            PG8_STAGE(PG8_SB(1, 1), b3 + hstep, voffB);
            PG8_WAIT_V(6); PG8_BAR; PG8_MMA(1, 1, At, B1); PG8_BAR;
            }
        }
        if constexpr (ALIGN_EPI) { if (wr == 0) PG8_BAR; }
        if constexpr (!Epi::AFTER_DRAIN) { E(acc, cur, wr, wc, fr, fq); S.done(cur); }
        if (!has_next) break;
#pragma unroll
        for (int a = 0; a < 2; ++a)
#pragma unroll
            for (int b = 0; b < 2; ++b)
#pragma unroll
                for (int m = 0; m < 4; ++m)
#pragma unroll
                    for (int n = 0; n < 2; ++n) acc[a][b][m][n] = (f32x4){0.f, 0.f, 0.f, 0.f};
        cur = nxt; cA = nA; cB = nB; ++ui;
        if constexpr (ALIGN_EPI) { if (wr == 1) PG8_BAR; }
    }
    PG8_WAIT_V(0);
    if constexpr (!ALIGN_EPI) { if (wr == 0) PG8_BAR; }
    PG8_BAR;
    if constexpr (Epi::AFTER_DRAIN) { E.fused(acc, cur, wr, wc, fr, fq, lds, wid, lane); S.done(cur); }
#undef PG8_SA
#undef PG8_SB
#undef PG8_STAGE
#undef PG8_LDA
#undef PG8_LDB
#undef PG8_MMA
#undef PG8_WAIT_V
#undef PG8_WAIT_L
#undef PG8_BAR
#undef PG8_SCHED
}
}

namespace mk {
using pg8::bf16_t; using pg8::bf16x8; using pg8::f32x4; using pg8::u32x4; using pg8::u32x2; using pg8::s16x4; using pg8::pk2; using pg8::lo16; using pg8::hi16; using pg8::bf2f;
#define DI __device__ __forceinline__
#define MFMA16(a, b, c) __builtin_amdgcn_mfma_f32_16x16x32_bf16((a), (b), (c), 0, 0, 0)
constexpr int NT = 512;
#ifndef GEMM_SP2
#define GEMM_SP2 true
#endif
#ifndef GEMM_ALIGN
#define GEMM_ALIGN true
#endif
constexpr size_t MiB = (size_t)1 << 20;
constexpr size_t WS_CTL = 0, WS_MOD = 65536, WS_TAB = 512 * 1024, WS_AB = 1 * MiB, WS_AQ = 4 * MiB, WS_AKV = 20 * MiB, WS_DQKV = 29 * MiB, WS_DZ = 83 * MiB, WS_WIN = 99 * MiB, WS_H = 109 * MiB,
                 WS_PREP = 99 * MiB, WS_SC = 243 * MiB, WS_YD = 20 * MiB, WS_OF = 36 * MiB, WS_OB = 52 * MiB, WS_WBR = 99 * MiB, WS_WOUT = 101 * MiB, WS_WM1 = 103 * MiB, WS_WM2 = 111 * MiB,
                 WS_Y = 119 * MiB, WS_H2 = 4 * MiB, WS_ROWSQ = 320 * 1024, WS_BIAS = 384 * 1024, WS_ACT = 119 * MiB, WS_END = 247 * MiB;
constexpr int LDS_BYTES = 131072 + 1024 + 18432;
constexpr float LOG2E = 1.4426950408889634f;

struct Params { const float* in[21]; float* out; unsigned char* ws; };

DI bf16x8 pack8(const f32x4 a, const f32x4 b) { u32x4 r; r.x = pk2(a[0], a[1]); r.y = pk2(a[2], a[3]); r.z = pk2(b[0], b[1]); r.w = pk2(b[2], b[3]); return __builtin_bit_cast(bf16x8, r); }
DI bf16x8 pack8r(const f32x4 a, const f32x4 b) { u32x4 r; r.x = pk2(a[3], a[2]); r.y = pk2(a[1], a[0]); r.z = pk2(b[3], b[2]); r.w = pk2(b[1], b[0]); return __builtin_bit_cast(bf16x8, r); }
DI bf16_t f2bf(float v) { return (bf16_t)(pk2(v, 0.f) & 0xffffu); }
DI float silu(float v) { return v / (1.0f + __expf(-v)); }
#define LBAR() asm volatile("s_waitcnt lgkmcnt(0)\n\ts_barrier" ::: "memory")

struct ConvT { const float* src; bf16_t* dst; int ldsrc, ldk, k0, n0, mode; };
DI void conv_load(const ConvT& c, int tid, float (&r)[16]) {
#pragma unroll
    for (int i = 0; i < 16; ++i) { const int e = tid + NT * i, kk = e >> 7, nn = e & 127, n = c.n0 + nn; int sc = n;
        if (c.mode == 1) { if (n >= 2816 && n < 4864) { const int t = n - 2816, gt = t >> 8, j = t & 255; sc = j < 128 ? 2848 + 128 * gt + j : 3872 + 128 * gt + (j - 128); } else sc = n < 2816 ? n : (n < 4896 ? n - 2048 : -1); }
        r[i] = sc >= 0 ? c.src[(size_t)(c.k0 + kk) * c.ldsrc + sc] : 0.f; }
}
#define CONV_TILES(first, stride, ntiles, DEC, tile, HOOK) do { int tid_ = threadIdx.x; asm volatile("" : "+v"(tid_)); const int ctid = tid_; float cr[16]; int ct = (first); \
    if (ct < (ntiles)) { const ConvT c0 = DEC(ct); conv_load(c0, ctid, cr); } \
    for (; ct < (ntiles); ct += (stride)) { const ConvT cc = DEC(ct); \
        _Pragma("unroll") for (int i = 0; i < 16; ++i) { const int e = ctid + NT * i; (tile)[(e >> 7) * 129 + (e & 127)] = cr[i]; } \
        LBAR(); \
        if (ct + (stride) < (ntiles)) { const ConvT cn = DEC(ct + (stride)); conv_load(cn, ctid, cr); } \
        HOOK(cc, ct, ctid, tile); \
        { const int nn = ctid >> 2, ks = (ctid & 3) * 16; const float* t = (tile) + ks * 129 + nn; u32x4 w0, w1; \
          w0.x = pk2(t[0], t[129]); w0.y = pk2(t[258], t[387]); w0.z = pk2(t[516], t[645]); w0.w = pk2(t[774], t[903]); \
          w1.x = pk2(t[1032], t[1161]); w1.y = pk2(t[1290], t[1419]); w1.z = pk2(t[1548], t[1677]); w1.w = pk2(t[1806], t[1935]); \
          bf16_t* d = cc.dst + (size_t)(cc.n0 + nn) * cc.ldk + cc.k0 + ks; *(u32x4*)d = w0; *(u32x4*)(d + 8) = w1; } \
        LBAR(); } } while (0)
#define NO_HOOK(cc, ct, ctid, tile) do {} while (0)
#define BIAS_HOOK(cc, ct, ctid, tile) do { if ((ct) >= 256 && (ct) < 768) { const int hb_ = __builtin_amdgcn_readfirstlane((ctid) >> 6), hn_ = (ctid) & 63; const float* sh_ = (const float*)(P.ws + WS_MOD) + (size_t)hb_ * 6144 + 3072 + (cc).k0; float ps0_ = 0.f, ps1_ = 0.f; \
        _Pragma("unroll 16") for (int kk_ = 0; kk_ < 64; ++kk_) { const float sv_ = sh_[kk_]; ps0_ += (tile)[kk_ * 129 + hn_] * sv_; ps1_ += (tile)[kk_ * 129 + 64 + hn_] * sv_; } \
        float* bp_ = (float*)(P.ws + WS_BIAS) + hb_ * 4096 + (cc).n0 + hn_; atomicAdd(bp_, ps0_); atomicAdd(bp_ + 64, ps1_); } } while (0)
DI ConvT dec_win(const Params& P, int t) { ConvT c; c.src = P.in[7]; c.dst = (bf16_t*)(P.ws + WS_WIN); c.ldsrc = 4896; c.ldk = 1024; c.k0 = (t & 15) * 64; c.n0 = (t >> 4) * 128; c.mode = 1; return c; }
DI ConvT dec_rest(const Params& P, int t) { ConvT c; c.mode = 0;
    if (t < 128) { const int br = t >> 6, tt = t & 63; c.src = P.in[15 + br]; c.dst = (bf16_t*)(P.ws + WS_WBR) + (size_t)br * 1024 * 512; c.ldsrc = 1024; c.ldk = 512; c.k0 = (tt & 7) * 64; c.n0 = (tt >> 3) * 128; }
    else if (t < 256) { const int tt = t - 128; c.src = P.in[17]; c.dst = (bf16_t*)(P.ws + WS_WOUT); c.ldsrc = 1024; c.ldk = 1024; c.k0 = (tt & 15) * 64; c.n0 = (tt >> 4) * 128; }
    else if (t < 768) { const int tt = t - 256; c.src = P.in[19]; c.dst = (bf16_t*)(P.ws + WS_WM1); c.ldsrc = 4096; c.ldk = 1024; c.k0 = (tt & 15) * 64; c.n0 = (tt >> 4) * 128; }
    else { const int tt = t - 768; c.src = P.in[20]; c.dst = (bf16_t*)(P.ws + WS_WM2); c.ldsrc = 1024; c.ldk = 4096; c.k0 = (tt & 63) * 64; c.n0 = (tt >> 6) * 128; }
    return c; }
DI void mod_item(const Params& P, int item, float* sil) {
    const int tid = threadIdx.x, ns = item % 12, ksl = item / 12;
    if (tid < 144) { const int r = tid >> 4, kk = tid & 15; const float v = r < 8 ? P.in[1][r * 1024 + ksl * 16 + kk] : P.in[3][ksl * 16 + kk]; sil[tid] = v / (1.0f + expf(-v)); }
    const int n = ns * 512 + tid; const float* w = P.in[4] + (size_t)(ksl * 16) * 6144 + n; float wv[16];
#pragma unroll
    for (int kk = 0; kk < 16; ++kk) wv[kk] = w[(size_t)kk * 6144];
    __syncthreads();
    float acc[9];
#pragma unroll
    for (int r = 0; r < 9; ++r) acc[r] = 0.f;
#pragma unroll
    for (int kk = 0; kk < 16; ++kk)
#pragma unroll
        for (int r = 0; r < 9; ++r) acc[r] += sil[r * 16 + kk] * wv[kk];
    float* mod = (float*)(P.ws + WS_MOD); const float bias = ksl == 0 ? P.in[5][n] : 0.f;
#pragma unroll
    for (int r = 0; r < 9; ++r) atomicAdd(mod + r * 6144 + n, acc[r] + bias);
    __syncthreads();
}

DI void modnorm_rows(const float* src_lat, const float* src_ctx, int nrows, const float* g, const float* mod, int sh_off, int sc_off, bf16_t* dst) {
    const int wave = threadIdx.x >> 6, lane = threadIdx.x & 63; const int stride = gridDim.x * 8;
    int row = blockIdx.x * 8 + wave; f32x4 v[4], gg[4], sc[4], sh[4];
#pragma unroll
    for (int j = 0; j < 4; ++j) gg[j] = *(const f32x4*)(g + j * 256 + lane * 4);
#define MN_LOAD(r, V, SC, SH) do { const float* src_ = (r) < 16384 ? src_lat + (size_t)(r) * 1024 : src_ctx + (size_t)((r) - 16384) * 1024; const float* mr_ = mod + (size_t)((r) < 16384 ? ((r) >> 11) : 8) * 6144; \
        _Pragma("unroll") for (int j = 0; j < 4; ++j) { V[j] = *(const f32x4*)(src_ + j * 256 + lane * 4); SC[j] = *(const f32x4*)(mr_ + sc_off + j * 256 + lane * 4); SH[j] = *(const f32x4*)(mr_ + sh_off + j * 256 + lane * 4); } } while (0)
    if (row < nrows) MN_LOAD(row, v, sc, sh);
    for (; row < nrows; row += stride) {
        const int nrow = row + stride; f32x4 vn[4], scn[4], shn[4];
#pragma unroll
        for (int j = 0; j < 4; ++j) { vn[j] = v[j]; scn[j] = sc[j]; shn[j] = sh[j]; }
        if (nrow < nrows) MN_LOAD(nrow, vn, scn, shn);
        float ss = 0.f;
#pragma unroll
        for (int j = 0; j < 4; ++j) ss += v[j][0] * v[j][0] + v[j][1] * v[j][1] + v[j][2] * v[j][2] + v[j][3] * v[j][3];
#pragma unroll
        for (int off = 32; off >= 1; off >>= 1) ss += __shfl_xor(ss, off);
        const float rstd = rsqrtf(ss * (1.0f / 1024.0f) + 1e-6f);
#pragma unroll
        for (int j = 0; j < 4; ++j) { const int col = j * 256 + lane * 4;
            const f32x4 hh = v[j] * rstd * gg[j] * (sc[j] + 1.0f) + sh[j]; u32x2 w; w.x = pk2(hh[0], hh[1]); w.y = pk2(hh[2], hh[3]); *(u32x2*)(dst + (size_t)row * 1024 + col) = w; }
#pragma unroll
        for (int j = 0; j < 4; ++j) { v[j] = vn[j]; sc[j] = scn[j]; sh[j] = shn[j]; }
    }
#undef MN_LOAD
}

DI int frag_idx(int row, int k) { return ((((row >> 4) * 2 + (k >> 5)) * 64) + (((k & 15) >> 2) * 16 + (row & 15))) * 8 + ((k >> 4) & 1) * 4 + (k & 3); }
DI float silu_fast(float v) { return v * __builtin_amdgcn_rcpf(1.0f + __expf(-v)); }
DI void prep_phase(const Params& P, unsigned char* smem) {
    int tid_ = threadIdx.x; asm volatile("" : "+v"(tid_)); const int tid = tid_, half = tid >> 8, hid = tid & 255, lane = tid & 63, w4 = (tid >> 6) & 3, dir = half;
    const int r2 = half, r4a = 2 + half;
    unsigned char* hb = smem + half * 64256;
    bf16_t* sQ = (bf16_t*)hb; bf16_t* sK = sQ + 64 * 72; bf16_t* sV = sK + 64 * 72; bf16_t* sAn = sV + 64 * 72; bf16_t* sXt = sAn + 64 * 72; float* sAd = (float*)(hb + 55296); bf16_t* sD = (bf16_t*)(hb + 60416);
    float* sG = (float*)(hb + 63488); float* sBeta = sG + 64; float* sEG = sBeta + 64;
    const bf16_t* DQKV = (const bf16_t*)(P.ws + WS_DQKV); const float* AB = (const float*)(P.ws + WS_AB);
    float* sCW = (float*)(smem + 132096);
    for (int e = tid; e < 1152; e += NT) *(f32x4*)(sCW + e * 4) = *(const f32x4*)(P.in[11] + e * 4);
    const float r_alog = P.in[12][lane & 15], r_dtb = P.in[13][lane & 15];
    LBAR();
    u32x4 ra[3][3]; float rda = 0.f, rdb = 0.f;
#define PREP_LOAD(it) do { const int ci_ = (it) % 36, bh_ = (it) / 36, h_ = bh_ & 7, b_ = bh_ >> 3; const bool lat_ = ci_ >= 4; \
        const int sb_ = lat_ ? b_ * 2048 : 16384 + b_ * 256, sl_ = lat_ ? 2048 : 256, t0_ = lat_ ? (ci_ - 4) * 64 : ci_ * 64, t_ = t0_ + (tid >> 3); \
        _Pragma("unroll") for (int tap = 0; tap < 3; ++tap) { int tt = t_ + tap - 1; tt = tt < 0 ? 0 : (tt >= sl_ ? sl_ - 1 : tt); const bf16_t* pr = DQKV + (size_t)(sb_ + tt) * 1536 + h_ * 64 + (tid & 7) * 8; \
            _Pragma("unroll") for (int T = 0; T < 3; ++T) ra[T][tap] = *(const u32x4*)(pr + T * 512); } \
        if (w4 == r2) { const int tl_ = t0_ + (dir ? 63 - lane : lane); const float* ab_ = AB + (size_t)(sb_ + tl_) * 32; const int j_ = dir * 8 + h_; rda = ab_[j_]; rdb = ab_[16 + j_]; } } while (0)
    if ((int)blockIdx.x < 2304) PREP_LOAD((int)blockIdx.x);
    for (int item = blockIdx.x; item < 2304; item += gridDim.x) {
    const int ci = item % 36, bh = item / 36, h = bh & 7; const bool lat = ci >= 4;
    const int seqlen = lat ? 2048 : 256, t0 = lat ? (ci - 4) * 64 : ci * 64;
    unsigned char* rec = P.ws + WS_PREP + (size_t)item * 65536;
    bf16_t* Wp = (bf16_t*)(rec + 16384 + dir * 24576); bf16_t* Up = Wp + 4096; bf16_t* Ip = Up + 4096;
    float* sc = (float*)(P.ws + WS_SC) + (size_t)(item * 2 + dir) * 192;
    { const int c = tid >> 3, seg = tid & 7, t = t0 + c;
      float mk[3]; mk[0] = t - 1 >= 0 ? 1.0f : 0.0f; mk[1] = 1.0f; mk[2] = t + 1 < seqlen ? 1.0f : 0.0f;
#pragma unroll
      for (int T = 0; T < 3; ++T) {
          float y[8];
#pragma unroll
          for (int e = 0; e < 8; ++e) y[e] = 0.f;
          const float* cw = sCW + T * 512 + h * 64 + seg * 8;
#pragma unroll
          for (int tap = 0; tap < 3; ++tap) { const u32x4 a0 = ra[T][tap]; const float* w = cw + tap * 1536; const float m = mk[tap];
              const f32x4 w0 = *(const f32x4*)w * m, w1 = *(const f32x4*)(w + 4) * m;
              y[0] += w0[0] * lo16(a0.x); y[1] += w0[1] * hi16(a0.x); y[2] += w0[2] * lo16(a0.y); y[3] += w0[3] * hi16(a0.y); y[4] += w1[0] * lo16(a0.z); y[5] += w1[1] * hi16(a0.z); y[6] += w1[2] * lo16(a0.w); y[7] += w1[3] * hi16(a0.w); }
#pragma unroll
          for (int e = 0; e < 8; ++e) { y[e] = silu_fast(y[e]); if (T == 0 && !lat) y[e] = 0.f; }
          if (T < 2) { float ss = 0.f;
#pragma unroll
              for (int e = 0; e < 8; ++e) ss += y[e] * y[e];
              ss += __shfl_xor(ss, 1); ss += __shfl_xor(ss, 2); ss += __shfl_xor(ss, 4); const float sn = rsqrtf(ss + 1e-6f) * (T == 0 ? 0.125f : 1.0f);
#pragma unroll
              for (int e = 0; e < 8; ++e) y[e] *= sn; }
          u32x4 o0; o0.x = pk2(y[0], y[1]); o0.y = pk2(y[2], y[3]); o0.z = pk2(y[4], y[5]); o0.w = pk2(y[6], y[7]);
          const int toff = T * 64 * 72 + seg * 8;
          *(u32x4*)((bf16_t*)smem + toff + c * 72) = o0; *(u32x4*)((bf16_t*)(smem + 64256) + toff + (63 - c) * 72) = o0;
      } }
    if (w4 == r2) { const int c = lane; const int j = dir * 8 + h;
        const float xa = rda + __shfl(r_dtb, j); const float sp = xa > 20.f ? xa : log1pf(__expf(xa));
        float G = -__expf(__shfl(r_alog, j)) * sp; const float beta = __builtin_amdgcn_rcpf(1.0f + __expf(-rdb));
#pragma unroll
        for (int off = 1; off < 64; off <<= 1) { const float v = __shfl_up(G, off); if (lane >= off) G += v; }
        const float gl = __shfl(G, 63), eg = __expf(G);
        sG[c] = G; sBeta[c] = beta; sEG[c] = eg; sc[c] = eg; sc[64 + c] = __expf(gl - G); if (c == 0) sc[128] = __expf(gl); }
    LBAR();
    if (item + (int)gridDim.x < 2304) PREP_LOAD(item + (int)gridDim.x);
    { const int r16 = lane & 15, q = lane >> 4, mb = w4; f32x4 kk[4], kq[4];
#pragma unroll
      for (int nb = 0; nb < 4; ++nb) { kk[nb] = (f32x4){0.f, 0.f, 0.f, 0.f}; kq[nb] = (f32x4){0.f, 0.f, 0.f, 0.f}; }
#pragma unroll
      for (int ks = 0; ks < 2; ++ks) { const bf16x8 ak = *(const bf16x8*)(sK + (16 * mb + r16) * 72 + 32 * ks + 8 * q);
#pragma unroll
          for (int nb = 0; nb < 4; ++nb) { const bf16x8 bk = *(const bf16x8*)(sK + (16 * nb + r16) * 72 + 32 * ks + 8 * q), bq = *(const bf16x8*)(sQ + (16 * nb + r16) * 72 + 32 * ks + 8 * q);
              kk[nb] = MFMA16(ak, bk, kk[nb]); kq[nb] = MFMA16(ak, bq, kq[nb]); } }
#pragma unroll
      for (int nb = 0; nb < 4; ++nb) {
#pragma unroll
          for (int i = 0; i < 4; ++i) { const int ri = 16 * mb + 4 * q + i, cj = 16 * nb + r16; float a = 0.f;
              if (nb <= mb) a = cj < ri ? sBeta[ri] * __expf(fminf(sG[ri] - sG[cj], 0.f)) * kk[nb][i] : 0.f;
              sAn[ri * 72 + cj] = f2bf(-a); if (nb == mb) sAd[(mb * 16 + 4 * q + i) * 20 + r16] = a; }
          if (lat && nb < mb) { *(u32x2*)(Ip + frag_idx(16 * nb + r16, 16 * mb + 4 * q)) = (u32x2){0u, 0u}; }
          if (lat && nb >= mb) { const int ri = 16 * nb + r16; const float gi = sG[ri]; float iv[4];
#pragma unroll
              for (int i = 0; i < 4; ++i) { const int cj = 16 * mb + 4 * q + i; iv[i] = cj <= ri ? __expf(fminf(gi - sG[cj], 0.f)) * kq[nb][i] : 0.f; }
              u32x2 wv; wv.x = pk2(iv[0], iv[1]); wv.y = pk2(iv[2], iv[3]); *(u32x2*)(Ip + frag_idx(ri, 16 * mb + 4 * q)) = wv; } }
    }
    LBAR();
    if (w4 == r4a) { const int bb = lane >> 4, j = lane & 15; float x[16];
        typedef __attribute__((address_space(3))) const f32x4* lcf4; const lcf4 ad = (lcf4)(sAd + bb * 16 * 20);
        x[0] = j == 0 ? 1.0f : 0.0f;
#define DIAG_ROWS(lo, hi) do { f32x4 ar[(hi) - (lo)][4]; \
        _Pragma("unroll") for (int i = (lo); i < (hi); ++i) _Pragma("unroll") for (int k4 = 0; k4 < i; k4 += 4) ar[i - (lo)][k4 >> 2] = ad[i * 5 + (k4 >> 2)]; \
        _Pragma("unroll") for (int i = (lo); i < (hi); ++i) { float sv = i == j ? 1.0f : 0.0f; \
            _Pragma("unroll") for (int k4 = 0; k4 < i; k4 += 4) { const f32x4 a = ar[i - (lo)][k4 >> 2]; sv -= a[0] * x[k4]; if (k4 + 1 < i) sv -= a[1] * x[k4 + 1]; if (k4 + 2 < i) sv -= a[2] * x[k4 + 2]; if (k4 + 3 < i) sv -= a[3] * x[k4 + 3]; } \
            x[i] = sv; } } while (0)
        DIAG_ROWS(1, 9); DIAG_ROWS(9, 13); DIAG_ROWS(13, 16);
#undef DIAG_ROWS
#pragma unroll
        for (int i = 0; i < 16; ++i) sD[(bb * 16 + i) * 24 + j] = f2bf(x[i]);
    } else { const int rk = (w4 - (w4 > r4a ? 1 : 0)) * 64 + lane;
      if (dir == 0) { bf16_t* Qf = (bf16_t*)rec; bf16_t* KTf = Qf + 4096;
        for (int fid = rk; fid < 512; fid += 192) { const int fmb = fid >> 7, ks = (fid >> 6) & 1, lf = fid & 63, qf = lf >> 4, fr = lf & 15; const int row = 16 * fmb + fr, k0 = 32 * ks + 4 * qf;
            if (lat) { const u32x2 a = *(const u32x2*)(sQ + row * 72 + k0), bq = *(const u32x2*)(sQ + row * 72 + k0 + 16); u32x4 wv; wv.x = a.x; wv.y = a.y; wv.z = bq.x; wv.w = bq.y; *(u32x4*)(Qf + fid * 8) = wv; }
            u32x4 wv; const bf16_t* kc = sK + row;
            wv.x = (unsigned)kc[(k0 + 0) * 72] | ((unsigned)kc[(k0 + 1) * 72] << 16); wv.y = (unsigned)kc[(k0 + 2) * 72] | ((unsigned)kc[(k0 + 3) * 72] << 16);
            wv.z = (unsigned)kc[(k0 + 16) * 72] | ((unsigned)kc[(k0 + 17) * 72] << 16); wv.w = (unsigned)kc[(k0 + 18) * 72] | ((unsigned)kc[(k0 + 19) * 72] << 16);
            *(u32x4*)(KTf + fid * 8) = wv; } }
      for (int o = rk; o < 1024; o += 192) *(u32x4*)(sXt + (o >> 3) * 72 + (o & 7) * 8) = (u32x4){0u, 0u, 0u, 0u};
    }
    LBAR();
    { const int r16 = lane & 15, q = lane >> 4;
#pragma unroll
      for (int bb = 0; bb < 4; ++bb) {
          f32x4 be;
#pragma unroll
          for (int i = 0; i < 4; ++i) { const int ri = 16 * bb + 4 * q + i; be[i] = w4 < 2 ? sBeta[ri] * sEG[ri] : sBeta[ri]; }
          const u32x2 dq = *(const u32x2*)(sD + (bb * 16 + r16) * 24 + 4 * q); u32x4 dfr; dfr.x = dq.x; dfr.y = dq.y; dfr.z = 0u; dfr.w = 0u;
#pragma unroll
          for (int t = 0; t < 2; ++t) { const int n0 = 32 * w4 + 16 * t + r16; const bf16_t* rsrc = (w4 < 2 ? sK + n0 : sV + (n0 - 64)) + (16 * bb + 4 * q) * 72;
              f32x4 acc; acc[0] = be[0] * bf2f(rsrc[0]); acc[1] = be[1] * bf2f(rsrc[72]); acc[2] = be[2] * bf2f(rsrc[144]); acc[3] = be[3] * bf2f(rsrc[216]);
#pragma unroll
              for (int ks = 0; ks < (bb + 1) / 2; ++ks) acc = MFMA16(*(const bf16x8*)(sAn + (16 * bb + r16) * 72 + 32 * ks + 8 * q), *(const bf16x8*)(sXt + n0 * 72 + 32 * ks + 8 * q), acc);
              u32x4 yb; yb.x = pk2(acc[0], acc[1]); yb.y = pk2(acc[2], acc[3]); yb.z = 0u; yb.w = 0u;
              const f32x4 z = MFMA16(__builtin_bit_cast(bf16x8, dfr), __builtin_bit_cast(bf16x8, yb), ((f32x4){0.f, 0.f, 0.f, 0.f}));
              u32x2 zw; zw.x = pk2(z[0], z[1]); zw.y = pk2(z[2], z[3]);
              *(u32x2*)(sXt + n0 * 72 + 16 * bb + 4 * q) = zw;
              if (w4 >= 2) { const int vs = 2 * (w4 - 2) + t; *(u32x2*)(Up + ((vs * 4 + bb) * 64 + lane) * 4) = zw; } }
          asm volatile("s_waitcnt lgkmcnt(0)" ::: "memory");
      }
      if (w4 < 2) {
#pragma unroll
          for (int mb = 0; mb < 4; ++mb) { const bf16_t* xc = sXt + (32 * w4 + 4 * q) * 72 + 16 * mb + r16; u32x4 wv;
              wv.x = ((unsigned)xc[0] | ((unsigned)xc[72] << 16)) ^ 0x80008000u; wv.y = ((unsigned)xc[144] | ((unsigned)xc[216] << 16)) ^ 0x80008000u;
              wv.z = ((unsigned)xc[16 * 72] | ((unsigned)xc[17 * 72] << 16)) ^ 0x80008000u; wv.w = ((unsigned)xc[18 * 72] | ((unsigned)xc[19 * 72] << 16)) ^ 0x80008000u;
              *(u32x4*)(Wp + ((mb * 2 + w4) * 64 + lane) * 8) = wv; } }
    }
    LBAR();
    }
}

DI void qk_normrope(const Params& P) {
    bf16_t* AQ = (bf16_t*)(P.ws + WS_AQ); bf16_t* AKV = (bf16_t*)(P.ws + WS_AKV); const float* TAB = (const float*)(P.ws + WS_TAB);
    for (int task = blockIdx.x * NT + threadIdx.x; task < 131072 + 36864; task += gridDim.x * NT) {
        bf16_t* ptr; const float* g; bool rope; int pos; float extra;
        if (task < 131072) { const int row = task >> 3, hd = task & 7; ptr = AQ + (size_t)row * 512 + hd * 64; g = P.in[8]; rope = true; pos = row & 2047; extra = 0.125f * LOG2E; }
        else { const int t2 = task - 131072, row = t2 >> 1, hd = t2 & 1; ptr = AKV + (size_t)row * 256 + hd * 64; g = P.in[9]; rope = row < 16384; pos = row & 2047; extra = 1.0f; }
        float v[64]; float ss = 0.f;
#pragma unroll
        for (int j = 0; j < 8; ++j) { const u32x4 a = *(const u32x4*)(ptr + j * 8); v[j * 8 + 0] = lo16(a.x); v[j * 8 + 1] = hi16(a.x); v[j * 8 + 2] = lo16(a.y); v[j * 8 + 3] = hi16(a.y); v[j * 8 + 4] = lo16(a.z); v[j * 8 + 5] = hi16(a.z); v[j * 8 + 6] = lo16(a.w); v[j * 8 + 7] = hi16(a.w); }
#pragma unroll
        for (int d = 0; d < 64; ++d) ss += v[d] * v[d];
        const float rs = rsqrtf(ss * (1.0f / 64.0f) + 1e-6f);
#pragma unroll
        for (int d = 0; d < 64; ++d) v[d] = v[d] * rs * g[d];
        if (rope) { const float* tr = TAB + (size_t)(pos >> 6) * 32; const float* tc = TAB + (size_t)(pos & 63) * 32;
#pragma unroll
            for (int f = 0; f < 16; ++f) { const float c1 = tr[2 * f], s1 = tr[2 * f + 1], c2 = tc[2 * f], s2 = tc[2 * f + 1];
                const float a1 = v[f], a2 = v[16 + f], b1 = v[32 + f], b2 = v[48 + f];
                v[f] = a1 * c1 - a2 * s1; v[16 + f] = a1 * s1 + a2 * c1; v[32 + f] = b1 * c2 - b2 * s2; v[48 + f] = b1 * s2 + b2 * c2; } }
#pragma unroll
        for (int j = 0; j < 8; ++j) { u32x4 w; w.x = pk2(v[j * 8] * extra, v[j * 8 + 1] * extra); w.y = pk2(v[j * 8 + 2] * extra, v[j * 8 + 3] * extra); w.z = pk2(v[j * 8 + 4] * extra, v[j * 8 + 5] * extra); w.w = pk2(v[j * 8 + 6] * extra, v[j * 8 + 7] * extra);
            *(u32x4*)(ptr + j * 8) = w; }
    }
}

#define SC_LAS __attribute__((address_space(3)))
DI int scan_chunk(int dir, int p) { return dir == 0 ? p : (p < 4 ? 3 - p : 39 - p); }
DI void scan_block(const Params& P, int sb, unsigned char* smem) {
    int tid_ = threadIdx.x; asm volatile("" : "+v"(tid_)); const int tid = tid_, lane = tid & 63, r16 = lane & 15, q = lane >> 4;
    const int w = __builtin_amdgcn_readfirstlane(tid >> 6), pair = sb >> 1, dir = sb & 1; const int b = pair >> 3, h = pair & 7;
    SC_LAS unsigned char* L = (SC_LAS unsigned char*)smem;
    const unsigned char* prep = P.ws + WS_PREP + (size_t)pair * 36 * 65536;
    __syncthreads();
    if (w >= 4) {
        const int m = w - 4; const int moff = m == 0 ? 16384 + dir * 24576 : (m == 1 ? 0 : (m == 2 ? 32768 + dir * 24576 : 8192));
#define SCAN_DMA(pp) do { const unsigned char* src_ = prep + (size_t)scan_chunk(dir, (pp)) * 65536 + moff + lane * 16; SC_LAS unsigned char* dst_ = L + ((pp) % 3) * 32768 + m * 8192; \
        _Pragma("unroll") for (int i_ = 0; i_ < 8; ++i_) __builtin_amdgcn_global_load_lds((const unsigned*)(src_ + i_ * 1024), (SC_LAS unsigned*)(dst_ + i_ * 1024), 16, 0, 0); } while (0)
        SCAN_DMA(0); SCAN_DMA(1);
        for (int p = 0; p < 36; ++p) {
            if (p + 1 < 36) asm volatile("s_waitcnt vmcnt(8)" ::: "memory"); else asm volatile("s_waitcnt vmcnt(0)" ::: "memory");
            __builtin_amdgcn_s_barrier();
            if (p + 2 < 36) SCAN_DMA(p + 2);
        }
#undef SCAN_DMA
    } else {
        const int vs = w; bf16_t* Oout = (bf16_t*)(P.ws + (dir ? WS_OB : WS_OF)); const float* scb = (const float*)(P.ws + WS_SC) + (size_t)pair * 36 * 2 * 192 + dir * 192;
#define SCAN_LDREG(pp, Ur, Eg, Tl, Egl) do { const int ci_ = scan_chunk(dir, (pp)); const bf16_t* Up_ = (const bf16_t*)(prep + (size_t)ci_ * 65536 + 16384 + dir * 24576 + 8192); const float* sc_ = scb + (size_t)ci_ * 384; \
        _Pragma("unroll") for (int mb_ = 0; mb_ < 4; ++mb_) { Ur[mb_] = *(const u32x2*)(Up_ + ((vs * 4 + mb_) * 64 + lane) * 4); Eg[mb_] = *(const f32x4*)(sc_ + 16 * mb_ + 4 * q); Tl[mb_] = *(const f32x4*)(sc_ + 64 + 16 * mb_ + 4 * q); } \
        Egl = sc_[128]; } while (0)
        f32x4 S[4];
#pragma unroll
        for (int r = 0; r < 4; ++r) S[r] = (f32x4){0.f, 0.f, 0.f, 0.f};
        u32x2 Uc[4]; f32x4 Egc[4], Tlc[4]; float Eglc; u32x2 opk[4]; int otb = -1;
#pragma unroll
        for (int mb = 0; mb < 4; ++mb) { opk[mb].x = 0u; opk[mb].y = 0u; }
#define SCAN_OSTORE() do { _Pragma("unroll") for (int mb_ = 0; mb_ < 4; ++mb_) { const int cp_ = 16 * mb_ + 4 * q; bf16_t* ob_ = Oout + (size_t)otb * 512 + h * 64 + 16 * vs + r16; const int st_ = dir ? -512 : 512; ob_ += (dir ? 63 - cp_ : cp_) * 512; \
        ob_[0] = (bf16_t)(opk[mb_].x & 0xffffu); ob_[st_] = (bf16_t)(opk[mb_].x >> 16); ob_[2 * st_] = (bf16_t)(opk[mb_].y & 0xffffu); ob_[3 * st_] = (bf16_t)(opk[mb_].y >> 16); } } while (0)
        SCAN_LDREG(0, Uc, Egc, Tlc, Eglc);
        for (int p = 0; p < 36; ++p) {
            asm volatile("s_waitcnt vmcnt(0)" ::: "memory"); __builtin_amdgcn_s_barrier(); asm volatile("" ::: "memory");
            if (otb >= 0) { SCAN_OSTORE(); otb = -1; }
            u32x2 Un[4]; f32x4 Egn[4], Tln[4]; float Egln = 0.f;
#pragma unroll
            for (int mb = 0; mb < 4; ++mb) { Un[mb] = Uc[mb]; Egn[mb] = Egc[mb]; Tln[mb] = Tlc[mb]; }
            if (p + 1 < 36) { SCAN_LDREG(p + 1, Un, Egn, Tln, Egln); }
            const int ci = scan_chunk(dir, p); const bool lat = ci >= 4;
            const SC_LAS unsigned char* B0 = L + (p % 3) * 32768;
#define SCAN_FRAG(m, idx) (*(const SC_LAS bf16x8*)(B0 + (m) * 8192 + (idx) * 16))
            bf16x8 Sb[2]; Sb[0] = pack8(S[0], S[1]); Sb[1] = pack8(S[2], S[3]);
            f32x4 u[4];
#pragma unroll
            for (int mb = 0; mb < 4; ++mb) { u[mb][0] = lo16(Uc[mb].x); u[mb][1] = hi16(Uc[mb].x); u[mb][2] = lo16(Uc[mb].y); u[mb][3] = hi16(Uc[mb].y); }
#pragma unroll
            for (int mb = 0; mb < 4; ++mb)
#pragma unroll
                for (int ks = 0; ks < 2; ++ks) u[mb] = MFMA16(SCAN_FRAG(0, (mb * 2 + ks) * 64 + lane), Sb[ks], u[mb]);
            if (lat) {
                f32x4 o[4];
#pragma unroll
                for (int mb = 0; mb < 4; ++mb) { o[mb] = (f32x4){0.f, 0.f, 0.f, 0.f};
#pragma unroll
                    for (int ks = 0; ks < 2; ++ks) { const int qi = dir ? (((3 - mb) * 2 + ks) * 64 + (lane ^ 15)) : ((mb * 2 + ks) * 64 + lane); o[mb] = MFMA16(SCAN_FRAG(1, qi), Sb[ks], o[mb]); }
                    o[mb] = o[mb] * Egc[mb]; }
                bf16x8 ub[2]; ub[0] = pack8(u[0], u[1]); ub[1] = pack8(u[2], u[3]);
#pragma unroll
                for (int mb = 0; mb < 4; ++mb)
#pragma unroll
                    for (int ks = 0; ks < 2; ++ks) o[mb] = MFMA16(SCAN_FRAG(2, (mb * 2 + ks) * 64 + lane), ub[ks], o[mb]);
                otb = b * 2048 + (ci - 4) * 64;
#pragma unroll
                for (int mb = 0; mb < 4; ++mb) { opk[mb].x = pk2(o[mb][0], o[mb][1]); opk[mb].y = pk2(o[mb][2], o[mb][3]); }
            }
            f32x4 u2[4];
#pragma unroll
            for (int mb = 0; mb < 4; ++mb) u2[mb] = u[mb] * Tlc[mb];
            bf16x8 ub2[2]; int kl;
            if (dir == 0) { ub2[0] = pack8(u2[0], u2[1]); ub2[1] = pack8(u2[2], u2[3]); kl = lane; }
            else { ub2[0] = pack8r(u2[3], u2[2]); ub2[1] = pack8r(u2[1], u2[0]); kl = (3 - q) * 16 + r16; }
#pragma unroll
            for (int r = 0; r < 4; ++r) { S[r] = S[r] * Eglc;
#pragma unroll
                for (int ks = 0; ks < 2; ++ks) S[r] = MFMA16(SCAN_FRAG(3, (r * 2 + ks) * 64 + kl), ub2[ks], S[r]); }
#pragma unroll
            for (int mb = 0; mb < 4; ++mb) { Uc[mb] = Un[mb]; Egc[mb] = Egn[mb]; Tlc[mb] = Tln[mb]; }
            Eglc = Egln;
        }
        if (otb >= 0) { SCAN_OSTORE(); }
#undef SCAN_OSTORE
#undef SCAN_FRAG
#undef SCAN_LDREG
    }
    asm volatile("s_waitcnt vmcnt(0) lgkmcnt(0)" ::: "memory"); __syncthreads();
}

DI void attn_phase(const Params& P, unsigned char* smem, unsigned* ctr, volatile int* sItem) {
    int tid_ = threadIdx.x; asm volatile("" : "+v"(tid_)); const int tid = tid_, w = tid >> 6, lane = tid & 63, r16 = lane & 15, q = lane >> 4;
    bf16_t* AQ = (bf16_t*)(P.ws + WS_AQ); const bf16_t* AKV = (const bf16_t*)(P.ws + WS_AKV);
    bf16_t* sK = (bf16_t*)smem; bf16_t* sVt = sK + 2 * 64 * 72;
    const int key = tid >> 3, seg = tid & 7;
    LBAR(); if (tid == 0) sItem[0] = (int)atomicAdd(ctr, 1u); LBAR();
    int item = sItem[0]; if (item >= 1024) return;
    bf16x8 Qb[2]; u32x4 kreg, vreg;
#define ATT_FIRST(it, Q0, Q1) do { const int b_ = (it) >> 7, qb_ = ((it) >> 3) & 15, hd_ = (it) & 7, q0_ = qb_ * 128, lo_ = q0_ - 128 < 0 ? 0 : q0_ - 128; \
        const bf16_t* qr_ = AQ + (size_t)(b_ * 2048 + q0_ + 16 * w + r16) * 512 + hd_ * 64; Q0 = *(const bf16x8*)(qr_ + 8 * q); Q1 = *(const bf16x8*)(qr_ + 32 + 8 * q); \
        const bf16_t* kp_ = AKV + (size_t)(b_ * 2048 + lo_ + key) * 256 + (hd_ >> 2) * 64 + seg * 8; kreg = *(const u32x4*)kp_; vreg = *(const u32x4*)(kp_ + 128); } while (0)
    ATT_FIRST(item, Qb[0], Qb[1]);
    for (;;) {
        if (tid == 0) sItem[1] = (int)atomicAdd(ctr, 1u);
        const int b = item >> 7, qb = (item >> 3) & 15, head = item & 7, g = head >> 2, q0 = qb * 128;
        const int qpos = q0 + 16 * w + r16; bf16_t* qrow = AQ + (size_t)(b * 2048 + qpos) * 512 + head * 64;
        float m = P.in[10][head] * LOG2E, l = q == 0 ? 1.0f : 0.0f; f32x4 O[4];
#pragma unroll
        for (int mb = 0; mb < 4; ++mb) O[mb] = (f32x4){0.f, 0.f, 0.f, 0.f};
        const int lo = q0 - 128 < 0 ? 0 : q0 - 128, hi = q0 + 256 > 2048 ? 2048 : q0 + 256, nloc = (hi - lo) >> 6, ntile = nloc + 4;
        int nxt = 1024; bf16x8 Qn[2]; Qn[0] = Qb[0]; Qn[1] = Qb[1];
        for (int j = 0; j < ntile; ++j) {
            const int buf = j & 1; bf16_t* bK = sK + buf * 64 * 72; bf16_t* bV = sVt + buf * 64 * 76;
            *(u32x4*)(bK + key * 72 + seg * 8) = kreg;
            { bf16_t* vp = bV + (seg * 8) * 76 + key; vp[0] = (bf16_t)(vreg.x & 0xffffu); vp[76] = (bf16_t)(vreg.x >> 16); vp[152] = (bf16_t)(vreg.y & 0xffffu); vp[228] = (bf16_t)(vreg.y >> 16);
              vp[304] = (bf16_t)(vreg.z & 0xffffu); vp[380] = (bf16_t)(vreg.z >> 16); vp[456] = (bf16_t)(vreg.w & 0xffffu); vp[532] = (bf16_t)(vreg.w >> 16); }
            LBAR();
            if (j == 0) nxt = sItem[1];
            if (j + 1 < ntile) { const int jn = j + 1; const int rb = jn < nloc ? b * 2048 + lo + 64 * jn : 16384 + b * 256 + 64 * (jn - nloc);
                const bf16_t* kp = AKV + (size_t)(rb + key) * 256 + g * 64 + seg * 8; kreg = *(const u32x4*)kp; vreg = *(const u32x4*)(kp + 128); }
            else if (nxt < 1024) { ATT_FIRST(nxt, Qn[0], Qn[1]); }
            const int kt0 = lo + 64 * j, qw0 = q0 + 16 * w;
            if (j < nloc && (kt0 + 63 < qw0 - 128 || kt0 > qw0 + 15 + 128)) continue;
            f32x4 s[4];
#pragma unroll
            for (int mb = 0; mb < 4; ++mb) { s[mb] = (f32x4){0.f, 0.f, 0.f, 0.f};
#pragma unroll
                for (int ks = 0; ks < 2; ++ks) s[mb] = MFMA16(*(const bf16x8*)(bK + (16 * mb + r16) * 72 + 32 * ks + 8 * q), Qb[ks], s[mb]); }
            if (j < nloc && (kt0 < qw0 + 15 - 128 || kt0 + 63 > qw0 + 128)) { const int kp0 = lo + 64 * j + 4 * q;
#pragma unroll
                for (int mb = 0; mb < 4; ++mb)
#pragma unroll
                    for (int i = 0; i < 4; ++i) { const int d = qpos - (kp0 + 16 * mb + i); if (d > 128 || d < -128) s[mb][i] = -1e30f; } }
            float tmax = -1e30f;
#pragma unroll
            for (int mb = 0; mb < 4; ++mb)
#pragma unroll
                for (int i = 0; i < 4; ++i) tmax = fmaxf(tmax, s[mb][i]);
            tmax = fmaxf(tmax, __shfl_xor(tmax, 16)); tmax = fmaxf(tmax, __shfl_xor(tmax, 32));
            const float mnew = fmaxf(m, tmax), alpha = __builtin_amdgcn_exp2f(m - mnew); m = mnew; float ls = 0.f;
#pragma unroll
            for (int mb = 0; mb < 4; ++mb)
#pragma unroll
                for (int i = 0; i < 4; ++i) { const float pv = __builtin_amdgcn_exp2f(s[mb][i] - mnew); s[mb][i] = pv; ls += pv; }
            l = l * alpha + ls;
#pragma unroll
            for (int mb = 0; mb < 4; ++mb) O[mb] = O[mb] * alpha;
            bf16x8 pb[2]; pb[0] = pack8(s[0], s[1]); pb[1] = pack8(s[2], s[3]);
#pragma unroll
            for (int mb = 0; mb < 4; ++mb)
#pragma unroll
                for (int ks = 0; ks < 2; ++ks) { const bf16_t* vp = bV + (16 * mb + r16) * 76 + 32 * ks + 4 * q; const u32x2 a = *(const u32x2*)vp, c2 = *(const u32x2*)(vp + 16); u32x4 av; av.x = a.x; av.y = a.y; av.z = c2.x; av.w = c2.y;
                    O[mb] = MFMA16(__builtin_bit_cast(bf16x8, av), pb[ks], O[mb]); }
        }
        l += __shfl_xor(l, 16); l += __shfl_xor(l, 32); const float inv = 1.0f / l;
#pragma unroll
        for (int mb = 0; mb < 4; ++mb) { u32x2 wv; wv.x = pk2(O[mb][0] * inv, O[mb][1] * inv); wv.y = pk2(O[mb][2] * inv, O[mb][3] * inv); *(u32x2*)(qrow + 16 * mb + 4 * q) = wv; }
        LBAR();
        if (nxt >= 1024) break;
        item = nxt; Qb[0] = Qn[0]; Qb[1] = Qn[1];
    }
#undef ATT_FIRST
}

DI void combine_yd(const Params& P) {
    const bf16_t* OF = (const bf16_t*)(P.ws + WS_OF); const bf16_t* OB = (const bf16_t*)(P.ws + WS_OB); const bf16_t* DZ = (const bf16_t*)(P.ws + WS_DZ); bf16_t* YD = (bf16_t*)(P.ws + WS_YD); const float* g = P.in[14];
    const int stride = gridDim.x * NT; int task = blockIdx.x * NT + threadIdx.x;
    u32x4 ar[2], cr[2], zr[2]; float gl[16];
#pragma unroll
    for (int e = 0; e < 16; ++e) gl[e] = g[(task & 3) * 16 + e];
    if (task < 524288) { const size_t off = (size_t)task * 16; ar[0] = *(const u32x4*)(OF + off); ar[1] = *(const u32x4*)(OF + off + 8); cr[0] = *(const u32x4*)(OB + off); cr[1] = *(const u32x4*)(OB + off + 8); zr[0] = *(const u32x4*)(DZ + off); zr[1] = *(const u32x4*)(DZ + off + 8); }
    for (; task < 524288; task += stride) {
        const size_t off = (size_t)task * 16; float v[16]; float ss = 0.f; u32x4 an[2], cn[2], zn[2];
#pragma unroll
        for (int j = 0; j < 2; ++j) { an[j] = ar[j]; cn[j] = cr[j]; zn[j] = zr[j]; }
        if (task + stride < 524288) { const size_t o2 = (size_t)(task + stride) * 16;
            an[0] = *(const u32x4*)(OF + o2); an[1] = *(const u32x4*)(OF + o2 + 8); cn[0] = *(const u32x4*)(OB + o2); cn[1] = *(const u32x4*)(OB + o2 + 8); zn[0] = *(const u32x4*)(DZ + o2); zn[1] = *(const u32x4*)(DZ + o2 + 8); }
#pragma unroll
        for (int j = 0; j < 2; ++j) { const u32x4 a = ar[j], c = cr[j];
            v[j * 8 + 0] = lo16(a.x) + lo16(c.x); v[j * 8 + 1] = hi16(a.x) + hi16(c.x); v[j * 8 + 2] = lo16(a.y) + lo16(c.y); v[j * 8 + 3] = hi16(a.y) + hi16(c.y);
            v[j * 8 + 4] = lo16(a.z) + lo16(c.z); v[j * 8 + 5] = hi16(a.z) + hi16(c.z); v[j * 8 + 6] = lo16(a.w) + lo16(c.w); v[j * 8 + 7] = hi16(a.w) + hi16(c.w); }
#pragma unroll
        for (int d = 0; d < 16; ++d) ss += v[d] * v[d];
        ss += __shfl_xor(ss, 1); ss += __shfl_xor(ss, 2);
        const float rs = rsqrtf(ss * (1.0f / 64.0f) + 1e-6f);
#pragma unroll
        for (int j = 0; j < 2; ++j) { const u32x4 z = zr[j]; float y[8];
            y[0] = silu(lo16(z.x)); y[1] = silu(hi16(z.x)); y[2] = silu(lo16(z.y)); y[3] = silu(hi16(z.y)); y[4] = silu(lo16(z.z)); y[5] = silu(hi16(z.z)); y[6] = silu(lo16(z.w)); y[7] = silu(hi16(z.w));
#pragma unroll
            for (int e = 0; e < 8; ++e) y[e] *= v[j * 8 + e] * rs * gl[j * 8 + e];
            u32x4 wv; wv.x = pk2(y[0], y[1]); wv.y = pk2(y[2], y[3]); wv.z = pk2(y[4], y[5]); wv.w = pk2(y[6], y[7]); *(u32x4*)(YD + off + j * 8) = wv; }
#pragma unroll
        for (int j = 0; j < 2; ++j) { ar[j] = an[j]; cr[j] = cn[j]; zr[j] = zn[j]; }
    }
}


DI void dadb_stage(const Params& P, unsigned char* smem) {
    const bf16_t* B = (const bf16_t*)(P.ws + WS_WIN) + (size_t)4864 * 1024;
#pragma unroll
    for (int i = 0; i < 8; ++i) { const int p = threadIdx.x + 512 * i, row = p >> 7, c8 = p & 127; *(u32x4*)((bf16_t*)smem + row * 1032 + c8 * 8) = *(const u32x4*)(B + (size_t)row * 1024 + c8 * 8); }
}
DI void dadb_task(const Params& P, int task, int lane, const unsigned char* smem) {
    const int r16 = lane & 15, q = lane >> 4; const bf16_t* A = (const bf16_t*)(P.ws + WS_H) + (size_t)(task * 16 + r16) * 1024 + 8 * q; const bf16_t* B = (const bf16_t*)smem + r16 * 1032 + 8 * q;
    f32x4 acc0 = (f32x4){0.f, 0.f, 0.f, 0.f}, acc1 = acc0; bf16x8 a[32];
#pragma unroll
    for (int ks = 0; ks < 32; ++ks) a[ks] = *(const bf16x8*)(A + 32 * ks);
    __builtin_amdgcn_sched_barrier(0);
#pragma unroll
    for (int ks = 0; ks < 32; ++ks) { acc0 = MFMA16(a[ks], *(const bf16x8*)(B + 32 * ks), acc0); acc1 = MFMA16(a[ks], *(const bf16x8*)(B + 16 * 1032 + 32 * ks), acc1); }
    float* AB = (float*)(P.ws + WS_AB) + (size_t)(task * 16 + 4 * q) * 32 + r16;
#pragma unroll
    for (int i = 0; i < 4; ++i) { AB[i * 32] = acc0[i]; AB[i * 32 + 16] = acc1[i]; }
}

#define XB_TMO      128
#define XB_XCNT(j)  (256  + 64 * (j))
#define XB_XSUB(j)  (1280 + 64 * (j))
#define XB_XGEN(j)  (2304 + 64 * (j))
#define XB_TOP      3328
#define XB_TOPGEN   3392
#define XCD_BAR_WORDS 3456
#define XB_SPIN_CAP (1u << 18)
#define LASB __attribute__((address_space(3)))
DI unsigned xb_ld(unsigned* p)              { return __hip_atomic_load(p, __ATOMIC_RELAXED, __HIP_MEMORY_SCOPE_AGENT); }
DI unsigned xb_add(unsigned* p, unsigned v) { return __hip_atomic_fetch_add(p, v, __ATOMIC_RELAXED, __HIP_MEMORY_SCOPE_AGENT); }
DI unsigned xb_xcc_id() { return (unsigned)__builtin_amdgcn_s_getreg((3 << 11) | 20) & 0xFu; }
#define XB_SPIN(cond, bar) do { unsigned _sp = 0; while (cond) { __builtin_amdgcn_s_sleep(1); \
    if ((++_sp & 255u) == 0u) { if (xb_ld(&(bar)[XB_TMO])) break; if (_sp > XB_SPIN_CAP) { atomicAdd(&(bar)[XB_TMO], 1u); break; } } } } while (0)
struct XcdBarrier { unsigned* bar; unsigned x; volatile LASB unsigned* st; };
DI XcdBarrier xcd_barrier_post(unsigned* bar, volatile LASB unsigned* st) {
    XcdBarrier b; b.bar = bar; b.x = xb_xcc_id(); b.st = st;
    if (threadIdx.x == 0) (void)xb_add(&bar[XB_XCNT(b.x)], 1u);
    return b;
}
DI void xcd_barrier_complete(unsigned* bar, unsigned x, unsigned& nloc, unsigned& nx) {
    const unsigned G = gridDim.x * gridDim.y * gridDim.z;
    unsigned sum, cnt, mine, sp = 0u;
    for (;;) {
        sum = 0u; cnt = 0u; mine = 0u;
#pragma unroll
        for (unsigned j = 0; j < 16; ++j) { const unsigned c = xb_ld(&bar[XB_XCNT(j)]); sum += c; cnt += (c > 0u) ? 1u : 0u; mine = (j == x) ? c : mine; }
        if (sum == G) break;
        __builtin_amdgcn_s_sleep(1);
        if ((++sp & 255u) == 0u) { if (xb_ld(&bar[XB_TMO])) break; if (sp > XB_SPIN_CAP) { atomicAdd(&bar[XB_TMO], 1u); break; } }
    }
    nloc = mine > 0u ? mine : 1u; nx = cnt > 0u ? cnt : 1u;
}
DI void xcd_barrier(const XcdBarrier& b) {
    asm volatile("s_waitcnt vmcnt(0)" ::: "memory");
    __syncthreads();
    if (threadIdx.x == 0) {
        unsigned* bar = b.bar;
        __builtin_amdgcn_s_waitcnt(0);
        unsigned nloc = b.st[0], nx = b.st[1];
        if (nloc == 0u) { xcd_barrier_complete(bar, b.x, nloc, nx); b.st[0] = nloc; b.st[1] = nx; }
        const unsigned old = xb_add(&bar[XB_XSUB(b.x)], 1u);
        const unsigned gen = old / nloc;
        if (old + 1u == (gen + 1u) * nloc) {
            __builtin_amdgcn_fence(__ATOMIC_RELEASE, "agent");
            asm volatile("s_waitcnt vmcnt(0)" ::: "memory");
            const unsigned og = xb_add(&bar[XB_TOP], 1u);
            const unsigned tg = og / nx;
            if (og + 1u == (tg + 1u) * nx) xb_add(&bar[XB_TOPGEN], 1u);
            else XB_SPIN(xb_ld(&bar[XB_TOPGEN]) == tg, bar);
            __builtin_amdgcn_fence(__ATOMIC_ACQUIRE, "agent");
            xb_add(&bar[XB_XGEN(b.x)], 1u);
            asm volatile("s_waitcnt vmcnt(0)" ::: "memory");
        } else {
            XB_SPIN(xb_ld(&bar[XB_XGEN(b.x)]) == gen, bar);
            __builtin_amdgcn_fence(__ATOMIC_ACQUIRE, "agent");
            asm volatile("s_waitcnt vmcnt(0)" ::: "memory");
        }
    }
    __syncthreads();
}

__global__ void __launch_bounds__(NT) fwd(Params P) {
    extern __shared__ __attribute__((aligned(16))) unsigned char lds[];
    cg::grid_group grid = cg::this_grid();
    const int tid = threadIdx.x, bid = blockIdx.x, G = gridDim.x;
    unsigned char* ws = P.ws;
    volatile int* sItem = (volatile int*)(lds + 131072);
    if (tid < 8) ((volatile LASB unsigned*)(lds + 131072 + 16))[tid] = 0u;
    __syncthreads();
    XcdBarrier xbar = xcd_barrier_post((unsigned*)(ws + 4096), (volatile LASB unsigned*)(lds + 131072 + 16));
    if (P.ws == nullptr) grid.sync();
#define GRID_SYNC() xcd_barrier(xbar)
    pg8::EpiP ep; ep.AQ = (bf16_t*)(ws + WS_AQ); ep.AKV = (bf16_t*)(ws + WS_AKV); ep.DQKV = (bf16_t*)(ws + WS_DQKV); ep.DZ = (bf16_t*)(ws + WS_DZ); ep.GATES = (bf16_t*)P.out; ep.Y = (bf16_t*)(ws + WS_Y);
    ep.AB = (float*)(ws + WS_AB); ep.x = P.in[0]; ep.mod = (const float*)(ws + WS_MOD); ep.out = P.out; ep.ACT = (bf16_t*)(ws + WS_ACT); ep.g2 = P.in[18]; ep.H2 = (bf16_t*)(ws + WS_H2); ep.rowsq = (float*)(ws + WS_ROWSQ); ep.bias = (const float*)(ws + WS_BIAS);
    PG8_LAS unsigned char* glds = (PG8_LAS unsigned char*)lds;

#ifdef PROBE_SYNC
    for (int i = 0; i < PROBE_SYNC; ++i) GRID_SYNC();
#endif
    { float* tile = (float*)lds;
#ifndef NO_P0
      for (int it = bid; it < 768; it += G) mod_item(P, it, tile);
#define DEC_WIN(t) dec_win(P, (t))
      __syncthreads(); CONV_TILES(bid, G, 624, DEC_WIN, tile, NO_HOOK);
      const int gt = bid * NT + tid; if (gt < 1024) { const int pos = gt >> 4, f = gt & 15; const float ang = (float)pos * powf(10000.0f, -(float)f / 16.0f); float* TAB = (float*)(ws + WS_TAB); TAB[2 * gt] = cosf(ang); TAB[2 * gt + 1] = sinf(ang); }
#endif
    }
    GRID_SYNC();
#ifndef NO_P1
#ifdef PROBE_P1
    for (int rep = 0; rep < PROBE_P1; ++rep)
#endif
    modnorm_rows(P.in[0], P.in[2], 18432, P.in[6], (const float*)(ws + WS_MOD), 0, 1024, (bf16_t*)(ws + WS_H));
#endif
    GRID_SYNC();
#ifndef NO_P2
#ifdef PROBE_G1
    for (int rep = 0; rep < PROBE_G1; ++rep)
#endif
    { pg8::Gemm g{(const bf16_t*)(ws + WS_H), (const bf16_t*)(ws + WS_WIN), 18432, 4864, 1024}; pg8::SchedIn S{G, bid}; pg8::Epi<0> E{ep}; pg8::gemm_phase<pg8::Epi<0>, pg8::SchedIn, GEMM_ALIGN, GEMM_SP2>(glds, g, S, E); }
    { dadb_stage(P, lds); __syncthreads();
    for (int task = (tid >> 6) * G + bid; task < 1152; task += G * 8) dadb_task(P, task, tid & 63, lds); }
#endif
    GRID_SYNC();
#ifndef NO_P4A
#ifdef PROBE_PREP
    for (int rep = 0; rep < PROBE_PREP; ++rep)
#endif
    prep_phase(P, lds);
#endif
#ifndef NO_P4B
    qk_normrope(P);
#endif
    GRID_SYNC();
#ifndef NO_P5A
#ifdef PROBE_SCAN
    for (int rep = 0; rep < PROBE_SCAN; ++rep)
#endif
    if (bid < 128) scan_block(P, bid, lds);
#endif
#ifndef NO_P5B
    attn_phase(P, lds, (unsigned*)(ws + WS_CTL), sItem);
#endif
    GRID_SYNC();
#ifndef NO_P6
#ifdef PROBE_EW
    for (int rep = 0; rep < PROBE_EW; ++rep) {
#else
    {
#endif
    combine_yd(P);
    { float* tile = (float*)lds;
#define DEC_REST(t) dec_rest(P, (t))
      __syncthreads(); CONV_TILES(bid, G, 1280, DEC_REST, tile, BIAS_HOOK); }
    }
#endif
    GRID_SYNC();
#ifndef NO_P7
#ifdef PROBE_G23
    for (int rep = 0; rep < PROBE_G23; ++rep)
#endif
    { pg8::Gemm g{(const bf16_t*)(ws + WS_AQ), (const bf16_t*)(ws + WS_WBR), 16384, 1024, 512, 16, 8, (size_t)16 * MiB - 1024, (size_t)1024 * 512 * 2 - 1024}; pg8::SchedStd S{4, 256, G, bid}; pg8::Epi<1> E{ep}; pg8::gemm_phase<pg8::Epi<1>, pg8::SchedStd, GEMM_ALIGN, GEMM_SP2>(glds, g, S, E); }
#endif
    GRID_SYNC();
#ifndef NO_P8
#ifdef PROBE_G23
    for (int rep = 0; rep < PROBE_G23; ++rep)
#endif
    { pg8::Gemm g{(const bf16_t*)(ws + WS_Y), (const bf16_t*)(ws + WS_WOUT), 16384, 1024, 1024}; pg8::SchedStd S{4, 256, G, bid}; pg8::Epi<2> E{ep}; pg8::gemm_phase<pg8::Epi<2>, pg8::SchedStd, GEMM_ALIGN, GEMM_SP2>(glds, g, S, E); }
#endif
    GRID_SYNC();
#ifndef NO_P10
#ifdef PROBE_G4
    for (int rep = 0; rep < PROBE_G4; ++rep)
#endif
    { pg8::Gemm g{(const bf16_t*)(ws + WS_H2), (const bf16_t*)(ws + WS_WM1), 16384, 4096, 1024}; pg8::SchedStd S{16, 1024, G, bid}; pg8::Epi<3> E{ep}; pg8::gemm_phase<pg8::Epi<3>, pg8::SchedStd, GEMM_ALIGN, GEMM_SP2>(glds, g, S, E); }
#endif
    GRID_SYNC();
#ifndef NO_P11
    { pg8::Gemm g{(const bf16_t*)(ws + WS_ACT), (const bf16_t*)(ws + WS_WM2), 16384, 1024, 4096}; pg8::SchedStd S{4, 256, G, bid}; pg8::Epi<4> E{ep}; pg8::gemm_phase<pg8::Epi<4>, pg8::SchedStd, GEMM_ALIGN, GEMM_SP2>(glds, g, S, E); }
#endif
}
}

extern "C" void kernel_launch(void* const* d_in, const int* in_sizes, int n_in, void* d_out, int out_size, void* d_ws, size_t ws_size, hipStream_t stream) {
    static int grid = 0;
    if (grid == 0) {
        if (n_in != 21 || ws_size < mk::WS_END) { fprintf(stderr, "kernel_launch: unexpected inputs (n_in %d, ws %zu)\n", n_in, ws_size); grid = -1; return; }
        int dev = 0, cus = 0, per_cu = 0;
        hipGetDevice(&dev); hipDeviceGetAttribute(&cus, hipDeviceAttributeMultiprocessorCount, dev);
        if (hipFuncSetAttribute((const void*)mk::fwd, hipFuncAttributeMaxDynamicSharedMemorySize, mk::LDS_BYTES) != hipSuccess) { fprintf(stderr, "kernel_launch: hipFuncSetAttribute failed\n"); grid = -1; return; }
        if (hipOccupancyMaxActiveBlocksPerMultiprocessor(&per_cu, (const void*)mk::fwd, mk::NT, mk::LDS_BYTES) != hipSuccess || per_cu < 1) { fprintf(stderr, "kernel_launch: occupancy query says %d\n", per_cu); per_cu = 1; }
        (void)hipGetLastError();
        grid = cus * 1;
        if (grid % 8 != 0 || grid < 64) { fprintf(stderr, "kernel_launch: unexpected CU count %d\n", cus); }
    }
    if (grid < 0) return;
    hipMemsetAsync((char*)d_ws + mk::WS_CTL, 0, 512 * 1024, stream);
    mk::Params p{};
    for (int i = 0; i < 21; ++i) p.in[i] = (const float*)d_in[i];
    p.out = (float*)d_out; p.ws = (unsigned char*)d_ws;
    void* args[] = {&p};
    hipError_t e = hipLaunchCooperativeKernel((const void*)mk::fwd, dim3(grid), dim3(mk::NT), args, mk::LDS_BYTES, stream);
    if (e != hipSuccess) fprintf(stderr, "cooperative launch failed: %s (grid %d)\n", hipGetErrorString(e), grid);
}
```

```cpp
#include <hip/hip_runtime.h>
#include <hip/hip_cooperative_groups.h>
#include <cstdio>
#include <cstdint>
namespace cg = cooperative_groups;

namespace pg8 {
#define PG8_LAS __attribute__((address_space(3)))
typedef unsigned short bf16_t;
typedef short bf16x8 __attribute__((ext_vector_type(8)));
typedef float f32x4 __attribute__((ext_vector_type(4)));
typedef unsigned u32x4 __attribute__((ext_vector_type(4)));
constexpr int BM = 256, BK = 64, HALF = 128, HTB = HALF * BK * 2  , STAGE_BYTES = 8 * HTB, NXCD = 8, WGM = 8;

__host__ __device__ __forceinline__ int lds_byte(int r, int c) { const int st = (r >> 4) * 2 + (c >> 5), rr = r & 15, cc = c & 31, ob = rr * 64 + cc * 2; return st * 1024 + (ob ^ (((ob >> 9) & 1) << 5)); }
__host__ __device__ __forceinline__ void stage_rc(int b, int& R, int& C) { const int st = b / 1024, sb = b % 1024, swz = sb ^ (((sb >> 9) & 1) << 5); R = (st >> 1) * 16 + swz / 64; C = (st & 1) * 32 + (swz % 64) / 2; }
__host__ __device__ __forceinline__ int perm32(int rho) { const int n = rho >> 4, i = rho & 15; return 8 * (i >> 2) + 4 * n + (i & 3); }

struct Unit { int pm, pn; };
struct Gemm { const bf16_t* A; const bf16_t* Bt; int M, N, K; int nt = 0, jt = 0; size_t ja = 0, jb = 0; };


typedef unsigned u32x2 __attribute__((ext_vector_type(2)));
typedef short s16x4 __attribute__((ext_vector_type(4)));
__device__ __forceinline__ unsigned pk2(float a, float b) { typedef __bf16 bv2 __attribute__((ext_vector_type(2))); bv2 v; v[0] = (__bf16)a; v[1] = (__bf16)b; return __builtin_bit_cast(unsigned, v); }
__device__ __forceinline__ float lo16(unsigned u) { return __uint_as_float(u << 16); }
__device__ __forceinline__ float hi16(unsigned u) { return __uint_as_float(u & 0xffff0000u); }
__device__ __forceinline__ float bf2f(bf16_t v) { return __uint_as_float(((unsigned)v) << 16); }

__device__ __forceinline__ void map_static(int L, int nwg, int nN, int& pm, int& pn) {
    const int q = nwg / NXCD, xcd = L % NXCD, off = L / NXCD, wgid = xcd * q + off;
    const int nig = WGM * nN, gid = wgid / nig; pm = gid * WGM + ((wgid % nig) % WGM); pn = (wgid % nig) / WGM;
}
struct SchedStd {
    int nN, nwg, G, c;
    __device__ __forceinline__ bool next(int i, Unit& u) const { const long L = (long)i * G + c; if (L >= nwg) return false; map_static((int)L, nwg, nN, u.pm, u.pn); return true; }
    __device__ __forceinline__ void a_ready(const Unit&) const {}
    __device__ __forceinline__ void done(const Unit&) const {}
};
struct SchedIn {
    int G, c;
    __device__ __forceinline__ bool next(int i, Unit& u) const {
        const long L = (long)i * G + c; if (L >= 1256) return false;
        if (L < 1216) map_static((int)L, 1216, 19, u.pm, u.pn);
        else { const int Lc = (int)L - 1216, t = Lc >> 3; u.pm = 64 + (Lc & 7); u.pn = t == 0 ? 2 : t + 4; }
        return true;
    }
    __device__ __forceinline__ void a_ready(const Unit&) const {}
    __device__ __forceinline__ void done(const Unit&) const {}
};
struct SchedBr {
    int G, c;
    __device__ __forceinline__ bool next(int i, Unit& u) const {
        const long L = (long)(i >> 1) * G + c; if (L >= 256) return false; const int br = i & 1; int pm, pn; map_static((int)L, 256, 4, pm, pn);
        u.pm = pm + 64 * br; u.pn = pn + 4 * br; return true;
    }
    __device__ __forceinline__ void a_ready(const Unit&) const {}
    __device__ __forceinline__ void done(const Unit&) const {}
};

struct EpiP { bf16_t* AQ; bf16_t* AKV; bf16_t* DQKV; bf16_t* DZ; bf16_t* GATES; bf16_t* Y; float* AB; const float* x; const float* mod; float* out; bf16_t* ACT; const float* g2; bf16_t* H2; float* rowsq; const float* bias; };
template <int MODE> struct Epi {
    static constexpr bool PERM = true, AFTER_DRAIN = false, HAS_MID = (MODE == 1);
    EpiP p;
    __device__ __forceinline__ void operator()(const f32x4 (&acc)[2][2][4][2], const Unit& u, int wr, int wc, int fr, int fq) const {
        if (MODE == 0) {
            const int pn = u.pn; const int row0 = u.pm * BM + wr * 64 + fr;
            if (pn >= 11) {
                const int colg = (pn - 11) * 128 + wc * 32 + 8 * fq;
#pragma unroll
                for (int ai = 0; ai < 2; ++ai)
#pragma unroll
                    for (int m = 0; m < 4; ++m) { bf16_t* rp = p.GATES + (size_t)(row0 + ai * HALF + m * 16) * 2048 + colg; f32x4 rr[2], sd[2];
#pragma unroll
                        for (int n = 0; n < 2; ++n)
#pragma unroll
                            for (int j = 0; j < 4; ++j) { const float ga = fminf(fmaxf(acc[ai][0][m][n][j], -30.f), 30.f), gd = fminf(fmaxf(acc[ai][1][m][n][j], -30.f), 30.f);
                                const float ea = 1.0f + __expf(-ga), ed = 1.0f + __expf(-gd), ia = __builtin_amdgcn_rcpf(ea); rr[n][j] = ed * ia; sd[n][j] = __builtin_amdgcn_rcpf(ed); }
                        u32x4 w; w.x = pk2(rr[0][0], rr[0][1]); w.y = pk2(rr[0][2], rr[0][3]); w.z = pk2(rr[1][0], rr[1][1]); w.w = pk2(rr[1][2], rr[1][3]); *(u32x4*)rp = w;
                        w.x = pk2(sd[0][0], sd[0][1]); w.y = pk2(sd[0][2], sd[0][3]); w.z = pk2(sd[1][0], sd[1][1]); w.w = pk2(sd[1][2], sd[1][3]); *(u32x4*)(rp + 1024) = w; }
                return;
            }
            bf16_t* base; int ld, cofs;
            if (pn < 2) { base = p.AQ; ld = 512; cofs = 0; } else if (pn == 2) { base = p.AKV; ld = 256; cofs = 512; } else if (pn < 9) { base = p.DQKV; ld = 1536; cofs = 768; }
            else { base = p.DZ; ld = 512; cofs = 2304; }
            const int colt = pn * BM - cofs + wc * 32 + 8 * fq;
#pragma unroll
            for (int ai = 0; ai < 2; ++ai)
#pragma unroll
                for (int m = 0; m < 4; ++m) { bf16_t* rp = base + (size_t)(row0 + ai * HALF + m * 16) * ld + colt;
#pragma unroll
                    for (int bj = 0; bj < 2; ++bj) { const f32x4 v0 = acc[ai][bj][m][0], v1 = acc[ai][bj][m][1];
                        u32x4 w; w.x = pk2(v0[0], v0[1]); w.y = pk2(v0[2], v0[3]); w.z = pk2(v1[0], v1[1]); w.w = pk2(v1[2], v1[3]); *(u32x4*)(rp + bj * HALF) = w; } }
        } else if (MODE == 1) {
            const int row0 = u.pm * BM + wr * 64 + fr, col0 = u.pn * BM + wc * 32 + 8 * fq;
#pragma unroll
            for (int ai = 0; ai < 2; ++ai) { u32x4 g[4][2];
#pragma unroll
                for (int m = 0; m < 4; ++m)
#pragma unroll
                    for (int bj = 0; bj < 2; ++bj) g[m][bj] = *(const u32x4*)(p.GATES + (size_t)(row0 + ai * HALF + m * 16) * 2048 + 1024 + col0 + bj * HALF);
#pragma unroll
                for (int m = 0; m < 4; ++m) { bf16_t* yp = p.Y + (size_t)(row0 + ai * HALF + m * 16) * 1024 + col0;
#pragma unroll
                    for (int bj = 0; bj < 2; ++bj) { const f32x4 a0 = acc[ai][bj][m][0], a1 = acc[ai][bj][m][1]; const u32x4 gg = g[m][bj];
                        u32x4 w; w.x = pk2(lo16(gg.x) * a0[0], hi16(gg.x) * a0[1]); w.y = pk2(lo16(gg.y) * a0[2], hi16(gg.y) * a0[3]); w.z = pk2(lo16(gg.z) * a1[0], hi16(gg.z) * a1[1]); w.w = pk2(lo16(gg.w) * a1[2], hi16(gg.w) * a1[3]);
                        *(u32x4*)(yp + bj * HALF) = w; } } }
        } else if (MODE == 2) {
            const int row0 = u.pm * BM + wr * 64 + fr, col0 = u.pn * BM + wc * 32 + 8 * fq; const float* mb = p.mod + (size_t)(u.pm >> 3) * 6144 + col0;
            f32x4 gv[2][2], hv[2][2];
#pragma unroll
            for (int bj = 0; bj < 2; ++bj)
#pragma unroll
                for (int n = 0; n < 2; ++n) { gv[bj][n] = *(const f32x4*)(mb + 2048 + bj * HALF + n * 4); hv[bj][n] = *(const f32x4*)(p.g2 + col0 + bj * HALF + n * 4) * (*(const f32x4*)(mb + 4096 + bj * HALF + n * 4) + 1.0f); }
#pragma unroll
            for (int ai = 0; ai < 2; ++ai)
#pragma unroll
                for (int mh = 0; mh < 2; ++mh) { f32x4 xb[2][2][2];
#pragma unroll
                    for (int mm = 0; mm < 2; ++mm)
#pragma unroll
                        for (int bj = 0; bj < 2; ++bj)
#pragma unroll
                            for (int n = 0; n < 2; ++n) xb[mm][bj][n] = __builtin_nontemporal_load((const f32x4*)(p.x + (size_t)(row0 + ai * HALF + (2 * mh + mm) * 16) * 1024 + col0 + bj * HALF + n * 4));
#pragma unroll
                    for (int mm = 0; mm < 2; ++mm) { const int m = 2 * mh + mm; const int row = row0 + ai * HALF + m * 16; const size_t off = (size_t)row * 1024 + col0; float ss = 0.f;
#pragma unroll
                        for (int bj = 0; bj < 2; ++bj) { f32x4 a2[2];
#pragma unroll
                            for (int n = 0; n < 2; ++n) { const f32x4 x1 = xb[mm][bj][n] + gv[bj][n] * acc[ai][bj][m][n];
                                *(f32x4*)(p.out + off + bj * HALF + n * 4) = x1; ss += x1[0] * x1[0] + x1[1] * x1[1] + x1[2] * x1[2] + x1[3] * x1[3]; a2[n] = x1 * hv[bj][n]; }
                            u32x4 w; w.x = pk2(a2[0][0], a2[0][1]); w.y = pk2(a2[0][2], a2[0][3]); w.z = pk2(a2[1][0], a2[1][1]); w.w = pk2(a2[1][2], a2[1][3]); *(u32x4*)(p.H2 + off + bj * HALF) = w; }
                        ss += __shfl_xor(ss, 16); ss += __shfl_xor(ss, 32); if (fq == 0) atomicAdd(p.rowsq + row, ss); } }
        } else if (MODE == 4) {
            const int row0 = u.pm * BM + wr * 64 + fr, col0 = u.pn * BM + wc * 32 + 8 * fq; const float* gt = p.mod + (size_t)(u.pm >> 3) * 6144 + 5120 + col0;
            f32x4 gv[2][2];
#pragma unroll
            for (int bj = 0; bj < 2; ++bj)
#pragma unroll
                for (int n = 0; n < 2; ++n) gv[bj][n] = *(const f32x4*)(gt + bj * HALF + n * 4);
#pragma unroll
            for (int ai = 0; ai < 2; ++ai) { f32x4 ob[4][2][2];
#pragma unroll
                for (int m = 0; m < 4; ++m)
#pragma unroll
                    for (int bj = 0; bj < 2; ++bj)
#pragma unroll
                        for (int n = 0; n < 2; ++n) ob[m][bj][n] = __builtin_nontemporal_load((const f32x4*)(p.out + (size_t)(row0 + ai * HALF + m * 16) * 1024 + col0 + bj * HALF + n * 4));
#pragma unroll
                for (int m = 0; m < 4; ++m) { const size_t off = (size_t)(row0 + ai * HALF + m * 16) * 1024 + col0;
#pragma unroll
                    for (int bj = 0; bj < 2; ++bj)
#pragma unroll
                        for (int n = 0; n < 2; ++n) *(f32x4*)(p.out + off + bj * HALF + n * 4) = ob[m][bj][n] + gv[bj][n] * acc[ai][bj][m][n]; } }
        } else {
            const int row0 = u.pm * BM + wr * 64 + fr, col0 = u.pn * BM + wc * 32 + 8 * fq; const float* bp = p.bias + (size_t)(u.pm >> 3) * 4096 + col0;
            f32x4 bv[2][2];
#pragma unroll
            for (int bj = 0; bj < 2; ++bj)
#pragma unroll
                for (int n = 0; n < 2; ++n) bv[bj][n] = *(const f32x4*)(bp + bj * HALF + n * 4);
            float rq[2][4];
#pragma unroll
            for (int ai = 0; ai < 2; ++ai)
#pragma unroll
                for (int m = 0; m < 4; ++m) rq[ai][m] = p.rowsq[row0 + ai * HALF + m * 16];
#pragma unroll
            for (int ai = 0; ai < 2; ++ai)
#pragma unroll
                for (int m = 0; m < 4; ++m) { const int row = row0 + ai * HALF + m * 16; bf16_t* rp = p.ACT + (size_t)row * 4096 + col0; const float rstd = rsqrtf(rq[ai][m] * (1.0f / 1024.0f) + 1e-6f);
#pragma unroll
                    for (int bj = 0; bj < 2; ++bj) { f32x4 v0 = acc[ai][bj][m][0] * rstd + bv[bj][0], v1 = acc[ai][bj][m][1] * rstd + bv[bj][1];
#pragma unroll
                        for (int j = 0; j < 4; ++j) { const float t0 = fmaxf(v0[j], 0.f), t1 = fmaxf(v1[j], 0.f); v0[j] = t0 * t0; v1[j] = t1 * t1; }
                        u32x4 w; w.x = pk2(v0[0], v0[1]); w.y = pk2(v0[2], v0[3]); w.z = pk2(v1[0], v1[1]); w.w = pk2(v1[2], v1[3]); *(u32x4*)(rp + bj * HALF) = w; } }
        }
    }
    __device__ __forceinline__ void mid(f32x4 (&acc)[2][2][4][2], const Unit& u, int wr, int wc, int fr, int fq) const {
        const int row0 = u.pm * BM + wr * 64 + fr, col0 = u.pn * BM + wc * 32 + 8 * fq;
        const bf16_t* gp = p.GATES + (size_t)row0 * 2048 + col0;
#pragma unroll
        for (int ai = 0; ai < 2; ++ai)
#pragma unroll
            for (int m = 0; m < 4; ++m) { asm volatile("" : "+v"(gp));
#pragma unroll
                for (int bj = 0; bj < 2; ++bj) { const u32x4 g = *(const u32x4*)(gp + bj * HALF);
                    acc[ai][bj][m][0][0] *= lo16(g.x); acc[ai][bj][m][0][1] *= hi16(g.x); acc[ai][bj][m][0][2] *= lo16(g.y); acc[ai][bj][m][0][3] *= hi16(g.y);
                    acc[ai][bj][m][1][0] *= lo16(g.z); acc[ai][bj][m][1][1] *= hi16(g.z); acc[ai][bj][m][1][2] *= lo16(g.w); acc[ai][bj][m][1][3] *= hi16(g.w); }
                gp += (m == 3 ? (HALF - 48) : 16) * 2048;
                if (m == 1 || m == 3) asm volatile("" ::: "memory"); }
    }
};

template <class Epi, class Sched, bool ALIGN_EPI = false, bool SP2 = false>
__device__ __forceinline__ void gemm_phase(PG8_LAS unsigned char* lds, const Gemm g, const Sched& S, const Epi& E) {
    int tid_ = threadIdx.x; asm volatile("" : "+v"(tid_)); const int tid = tid_, wid = __builtin_amdgcn_readfirstlane(tid >> 6), lane = tid & 63, wr = wid >> 2, wc = wid & 3, fr = lane & 15, fq = lane >> 4;
    const int K = g.K, nt = g.nt ? g.nt : K / BK;
    unsigned voffA[2], voffB[2];
#pragma unroll
    for (int i = 0; i < 2; ++i) { int R, C; stage_rc(tid * 16 + i * 8192, R, C); const int Rb = Epi::PERM ? ((R & ~31) + perm32(R & 31)) : R;
        voffA[i] = (unsigned)(R * K + C) * 2u; voffB[i] = (unsigned)(Rb * K + C) * 2u; }
    const size_t kstep = (size_t)(BK * 2);
    const size_t hstep = (size_t)HALF * K * 2;
    const size_t tstep = 2 * hstep;
    const unsigned ldsw = (unsigned)wid * 1024u;
    const int aoff = lds_byte(wr * 64 + fr, fq * 8), boff = lds_byte(wc * 32 + fr, fq * 8);
#define PG8_SA(b, h) (((b) * 2 + (h)) * HTB)
#define PG8_SB(b, h) ((4 + (b) * 2 + (h)) * HTB)
#define PG8_STAGE(bufoff, gbase, voff) do { _Pragma("unroll") for (int _i = 0; _i < 2; ++_i) \
        __builtin_amdgcn_global_load_lds((const unsigned*)((const char*)(gbase) + (voff)[_i]), (PG8_LAS unsigned*)(lds + (bufoff) + ldsw + _i * 8192), 16, 0, 0); } while (0)
#define PG8_LDA(dst, b, h) do { _Pragma("unroll") for (int m = 0; m < 4; ++m) _Pragma("unroll") for (int k = 0; k < 2; ++k) dst[m][k] = *(const PG8_LAS bf16x8*)(lds + PG8_SA(b, h) + aoff + m * 2048 + k * 1024); } while (0)
#define PG8_LDB(dst, b, h) do { _Pragma("unroll") for (int n = 0; n < 2; ++n) _Pragma("unroll") for (int k = 0; k < 2; ++k) dst[n][k] = *(const PG8_LAS bf16x8*)(lds + PG8_SB(b, h) + boff + n * 2048 + k * 1024); } while (0)
#define PG8_MMA(ai, bj, At, Bt) do { __builtin_amdgcn_s_setprio(1); _Pragma("unroll") for (int m = 0; m < 4; ++m) _Pragma("unroll") for (int n = 0; n < 2; ++n) _Pragma("unroll") for (int k = 0; k < 2; ++k) \
        acc[ai][bj][m][n] = __builtin_amdgcn_mfma_f32_16x16x32_bf16(Bt[n][k], At[m][k], acc[ai][bj][m][n], 0, 0, 0); __builtin_amdgcn_s_setprio(0); } while (0)
#define PG8_WAIT_V(n) asm volatile("s_waitcnt vmcnt(" #n ")" ::: "memory")
#define PG8_WAIT_L(n) asm volatile("s_waitcnt lgkmcnt(" #n ")" ::: "memory")
#define PG8_BAR __builtin_amdgcn_s_barrier()
#define PG8_SCHED __builtin_amdgcn_sched_barrier(0)
    Unit cur, nxt; int ui = 0;
    if (!S.next(0, cur)) return;
    f32x4 acc[2][2][4][2];
#pragma unroll
    for (int a = 0; a < 2; ++a)
#pragma unroll
        for (int b = 0; b < 2; ++b)
#pragma unroll
            for (int m = 0; m < 4; ++m)
#pragma unroll
                for (int n = 0; n < 2; ++n) acc[a][b][m][n] = (f32x4){0.f, 0.f, 0.f, 0.f};
    bf16x8 At[4][2], B0[2][2], B1[2][2];
    const char* cA = (const char*)g.A + (size_t)cur.pm * tstep; const char* cB = (const char*)g.Bt + (size_t)cur.pn * tstep;
    S.a_ready(cur);
    if constexpr (SP2) {
        PG8_STAGE(PG8_SB(0, 0), cB, voffB); PG8_STAGE(PG8_SB(0, 1), cB + hstep, voffB); PG8_STAGE(PG8_SA(0, 0), cA, voffA); PG8_STAGE(PG8_SA(0, 1), cA + hstep, voffA);
        if (wr == 1) PG8_BAR;
        PG8_WAIT_V(2); PG8_BAR;
        PG8_STAGE(PG8_SB(1, 0), cB + kstep, voffB); PG8_STAGE(PG8_SA(1, 0), cA + kstep, voffA); PG8_STAGE(PG8_SB(1, 1), cB + hstep + kstep, voffB);
        PG8_WAIT_V(6); PG8_BAR;
    } else {
        PG8_STAGE(PG8_SB(0, 0), cB, voffB); PG8_STAGE(PG8_SA(0, 0), cA, voffA); PG8_STAGE(PG8_SB(0, 1), cB + hstep, voffB); PG8_STAGE(PG8_SA(0, 1), cA + hstep, voffA);
        if (wr == 1) PG8_BAR;
        PG8_WAIT_V(4); PG8_BAR;
        PG8_STAGE(PG8_SB(1, 0), cB + kstep, voffB); PG8_STAGE(PG8_SA(1, 0), cA + kstep, voffA); PG8_STAGE(PG8_SB(1, 1), cB + hstep + kstep, voffB);
        PG8_WAIT_V(6); PG8_BAR;
    }
    for (;;) {
        const bool has_next = S.next(ui + 1, nxt);
        const char* nA = has_next ? (const char*)g.A + (size_t)nxt.pm * tstep : cA; const char* nB = has_next ? (const char*)g.Bt + (size_t)nxt.pn * tstep : cB;
        for (int t = 0; t < nt; t += 2) {
            const bool last = (t == nt - 2);
            const size_t j1a = (g.jt && t + 1 >= g.jt) ? g.ja : 0, j2a = (g.jt && t + 2 >= g.jt) ? g.ja : 0, j2b = (g.jt && t + 2 >= g.jt) ? g.jb : 0;
            const char* a1 = cA + (size_t)(t + 1) * kstep + j1a;
            const char* a2 = last ? nA : cA + (size_t)(t + 2) * kstep + j2a; const char* b2 = last ? nB : cB + (size_t)(t + 2) * kstep + j2b;
            if constexpr (Epi::HAS_MID) { if (g.jt && t == g.jt) E.mid(acc, cur, wr, wc, fr, fq); }
            const char* a3 = a2 + kstep; const char* b3 = b2 + kstep;
            if (last && has_next) S.a_ready(nxt);
            if constexpr (SP2) {
            PG8_LDB(B0, 0, 0); PG8_LDB(B1, 0, 1); PG8_SCHED; PG8_LDA(At, 0, 0); PG8_STAGE(PG8_SA(1, 1), a1 + hstep, voffA);
            PG8_WAIT_V(8); PG8_WAIT_L(0); PG8_BAR; PG8_MMA(0, 0, At, B0); PG8_MMA(0, 1, At, B1); PG8_BAR; PG8_SCHED;
            PG8_LDA(At, 0, 1); PG8_STAGE(PG8_SB(0, 0), b2, voffB); PG8_STAGE(PG8_SB(0, 1), b2 + hstep, voffB); PG8_STAGE(PG8_SA(0, 0), a2, voffA);
            PG8_WAIT_V(8); PG8_WAIT_L(0); PG8_BAR; PG8_MMA(1, 0, At, B0); PG8_MMA(1, 1, At, B1); PG8_BAR; PG8_SCHED;
            PG8_LDB(B0, 1, 0); PG8_LDB(B1, 1, 1); PG8_SCHED; PG8_LDA(At, 1, 0); PG8_STAGE(PG8_SA(0, 1), a2 + hstep, voffA);
            PG8_WAIT_V(8); PG8_WAIT_L(0); PG8_BAR; PG8_MMA(0, 0, At, B0); PG8_MMA(0, 1, At, B1); PG8_BAR; PG8_SCHED;
            PG8_LDA(At, 1, 1); PG8_STAGE(PG8_SB(1, 0), b3, voffB); PG8_STAGE(PG8_SB(1, 1), b3 + hstep, voffB); PG8_STAGE(PG8_SA(1, 0), a3, voffA);
            PG8_WAIT_V(8); PG8_WAIT_L(0); PG8_BAR; PG8_MMA(1, 0, At, B0); PG8_MMA(1, 1, At, B1); PG8_BAR; PG8_SCHED;
            } else {
            PG8_LDB(B0, 0, 0); PG8_SCHED; PG8_LDA(At, 0, 0); PG8_STAGE(PG8_SA(1, 1), a1 + hstep, voffA);
            PG8_WAIT_L(8); PG8_BAR; PG8_WAIT_L(0); PG8_MMA(0, 0, At, B0); PG8_BAR; PG8_SCHED;
            PG8_LDB(B1, 0, 1); PG8_STAGE(PG8_SB(0, 0), b2, voffB);
            PG8_BAR; PG8_WAIT_L(0); PG8_MMA(0, 1, At, B1); PG8_BAR;
            PG8_LDA(At, 0, 1); PG8_STAGE(PG8_SA(0, 0), a2, voffA);
            PG8_BAR; PG8_WAIT_L(0); PG8_MMA(1, 0, At, B0); PG8_BAR; PG8_SCHED;
            PG8_STAGE(PG8_SB(0, 1), b2 + hstep, voffB);
            PG8_WAIT_V(6); PG8_BAR; PG8_MMA(1, 1, At, B1); PG8_BAR;
            PG8_LDB(B0, 1, 0); PG8_SCHED; PG8_LDA(At, 1, 0); PG8_STAGE(PG8_SA(0, 1), a2 + hstep, voffA);
            PG8_WAIT_L(8); PG8_BAR; PG8_WAIT_L(0); PG8_MMA(0, 0, At, B0); PG8_BAR; PG8_SCHED;
            PG8_LDB(B1, 1, 1); PG8_STAGE(PG8_SB(1, 0), b3, voffB);
            PG8_BAR; PG8_WAIT_L(0); PG8_MMA(0, 1, At, B1); PG8_BAR;
            PG8_LDA(At, 1, 1); PG8_STAGE(PG8_SA(1, 0), a3, voffA);
            PG8_BAR; PG8_WAIT_L(0); PG8_MMA(1, 0, At, B0); PG8_BAR; PG8_SCHED;
            PG8_STAGE(PG8_SB(1, 1), b3 + hstep, voffB);
            PG8_WAIT_V(6); PG8_BAR; PG8_MMA(1, 1, At, B1); PG8_BAR;
            }
        }
        if constexpr (ALIGN_EPI) { if (wr == 0) PG8_BAR; }
        if constexpr (!Epi::AFTER_DRAIN) { E(acc, cur, wr, wc, fr, fq); S.done(cur); }
        if (!has_next) break;
#pragma unroll
        for (int a = 0; a < 2; ++a)
#pragma unroll
            for (int b = 0; b < 2; ++b)
#pragma unroll
                for (int m = 0; m < 4; ++m)
#pragma unroll
                    for (int n = 0; n < 2; ++n) acc[a][b][m][n] = (f32x4){0.f, 0.f, 0.f, 0.f};
        cur = nxt; cA = nA; cB = nB; ++ui;
        if constexpr (ALIGN_EPI) { if (wr == 1) PG8_BAR; }
    }
    PG8_WAIT_V(0);
    if constexpr (!ALIGN_EPI) { if (wr == 0) PG8_BAR; }
    PG8_BAR;
    if constexpr (Epi::AFTER_DRAIN) { E.fused(acc, cur, wr, wc, fr, fq, lds, wid, lane); S.done(cur); }
#undef PG8_SA
#undef PG8_SB
#undef PG8_STAGE
#undef PG8_LDA
#undef PG8_LDB
#undef PG8_MMA
#undef PG8_WAIT_V
#undef PG8_WAIT_L
#undef PG8_BAR
#undef PG8_SCHED
}
}

namespace mk {
using pg8::bf16_t; using pg8::bf16x8; using pg8::f32x4; using pg8::u32x4; using pg8::u32x2; using pg8::s16x4; using pg8::pk2; using pg8::lo16; using pg8::hi16; using pg8::bf2f;
#define DI __device__ __forceinline__
#define MFMA16(a, b, c) __builtin_amdgcn_mfma_f32_16x16x32_bf16((a), (b), (c), 0, 0, 0)
constexpr int NT = 512;
#ifndef GEMM_SP2
#define GEMM_SP2 true
#endif
#ifndef GEMM_ALIGN
#define GEMM_ALIGN true
#endif
constexpr size_t MiB = (size_t)1 << 20;
constexpr size_t WS_CTL = 0, WS_MOD = 65536, WS_TAB = 512 * 1024, WS_AB = 1 * MiB, WS_AQ = 4 * MiB, WS_AKV = 20 * MiB, WS_DQKV = 29 * MiB, WS_DZ = 83 * MiB, WS_WIN = 99 * MiB, WS_H = 109 * MiB,
                 WS_PREP = 99 * MiB, WS_SC = 243 * MiB, WS_YD = 20 * MiB, WS_OF = 36 * MiB, WS_OB = 52 * MiB, WS_WBR = 99 * MiB, WS_WOUT = 101 * MiB, WS_WM1 = 103 * MiB, WS_WM2 = 111 * MiB,
                 WS_Y = 119 * MiB, WS_H2 = 4 * MiB, WS_ROWSQ = 320 * 1024, WS_BIAS = 384 * 1024, WS_ACT = 119 * MiB, WS_END = 247 * MiB;
constexpr int LDS_BYTES = 131072 + 1024 + 18432;
constexpr float LOG2E = 1.4426950408889634f;

struct Params { const float* in[21]; float* out; unsigned char* ws; };

DI bf16x8 pack8(const f32x4 a, const f32x4 b) { u32x4 r; r.x = pk2(a[0], a[1]); r.y = pk2(a[2], a[3]); r.z = pk2(b[0], b[1]); r.w = pk2(b[2], b[3]); return __builtin_bit_cast(bf16x8, r); }
DI bf16x8 pack8r(const f32x4 a, const f32x4 b) { u32x4 r; r.x = pk2(a[3], a[2]); r.y = pk2(a[1], a[0]); r.z = pk2(b[3], b[2]); r.w = pk2(b[1], b[0]); return __builtin_bit_cast(bf16x8, r); }
DI bf16_t f2bf(float v) { return (bf16_t)(pk2(v, 0.f) & 0xffffu); }
DI float silu(float v) { return v / (1.0f + __expf(-v)); }
#define LBAR() asm volatile("s_waitcnt lgkmcnt(0)\n\ts_barrier" ::: "memory")

struct ConvT { const float* src; bf16_t* dst; int ldsrc, ldk, k0, n0, mode; };
DI void conv_load(const ConvT& c, int tid, float (&r)[16]) {
#pragma unroll
    for (int i = 0; i < 16; ++i) { const int e = tid + NT * i, kk = e >> 7, nn = e & 127, n = c.n0 + nn; int sc = n;
        if (c.mode == 1) { if (n >= 2816 && n < 4864) { const int t = n - 2816, gt = t >> 8, j = t & 255; sc = j < 128 ? 2848 + 128 * gt + j : 3872 + 128 * gt + (j - 128); } else sc = n < 2816 ? n : (n < 4896 ? n - 2048 : -1); }
        r[i] = sc >= 0 ? c.src[(size_t)(c.k0 + kk) * c.ldsrc + sc] : 0.f; }
}
#define CONV_TILES(first, stride, ntiles, DEC, tile, HOOK) do { int tid_ = threadIdx.x; asm volatile("" : "+v"(tid_)); const int ctid = tid_; float cr[16]; int ct = (first); \
    if (ct < (ntiles)) { const ConvT c0 = DEC(ct); conv_load(c0, ctid, cr); } \
    for (; ct < (ntiles); ct += (stride)) { const ConvT cc = DEC(ct); \
        _Pragma("unroll") for (int i = 0; i < 16; ++i) { const int e = ctid + NT * i; (tile)[(e >> 7) * 129 + (e & 127)] = cr[i]; } \
        LBAR(); \
        if (ct + (stride) < (ntiles)) { const ConvT cn = DEC(ct + (stride)); conv_load(cn, ctid, cr); } \
        HOOK(cc, ct, ctid, tile); \
        { const int nn = ctid >> 2, ks = (ctid & 3) * 16; const float* t = (tile) + ks * 129 + nn; u32x4 w0, w1; \
          w0.x = pk2(t[0], t[129]); w0.y = pk2(t[258], t[387]); w0.z = pk2(t[516], t[645]); w0.w = pk2(t[774], t[903]); \
          w1.x = pk2(t[1032], t[1161]); w1.y = pk2(t[1290], t[1419]); w1.z = pk2(t[1548], t[1677]); w1.w = pk2(t[1806], t[1935]); \
          bf16_t* d = cc.dst + (size_t)(cc.n0 + nn) * cc.ldk + cc.k0 + ks; *(u32x4*)d = w0; *(u32x4*)(d + 8) = w1; } \
        LBAR(); } } while (0)
#define NO_HOOK(cc, ct, ctid, tile) do {} while (0)
#define BIAS_HOOK(cc, ct, ctid, tile) do { if ((ct) >= 256 && (ct) < 768) { const int hb_ = __builtin_amdgcn_readfirstlane((ctid) >> 6), hn_ = (ctid) & 63; const float* sh_ = (const float*)(P.ws + WS_MOD) + (size_t)hb_ * 6144 + 3072 + (cc).k0; float ps0_ = 0.f, ps1_ = 0.f; \
        _Pragma("unroll 16") for (int kk_ = 0; kk_ < 64; ++kk_) { const float sv_ = sh_[kk_]; ps0_ += (tile)[kk_ * 129 + hn_] * sv_; ps1_ += (tile)[kk_ * 129 + 64 + hn_] * sv_; } \
        float* bp_ = (float*)(P.ws + WS_BIAS) + hb_ * 4096 + (cc).n0 + hn_; atomicAdd(bp_, ps0_); atomicAdd(bp_ + 64, ps1_); } } while (0)
DI ConvT dec_win(const Params& P, int t) { ConvT c; c.src = P.in[7]; c.dst = (bf16_t*)(P.ws + WS_WIN); c.ldsrc = 4896; c.ldk = 1024; c.k0 = (t & 15) * 64; c.n0 = (t >> 4) * 128; c.mode = 1; return c; }
DI ConvT dec_rest(const Params& P, int t) { ConvT c; c.mode = 0;
    if (t < 128) { const int br = t >> 6, tt = t & 63; c.src = P.in[15 + br]; c.dst = (bf16_t*)(P.ws + WS_WBR) + (size_t)br * 1024 * 512; c.ldsrc = 1024; c.ldk = 512; c.k0 = (tt & 7) * 64; c.n0 = (tt >> 3) * 128; }
    else if (t < 256) { const int tt = t - 128; c.src = P.in[17]; c.dst = (bf16_t*)(P.ws + WS_WOUT); c.ldsrc = 1024; c.ldk = 1024; c.k0 = (tt & 15) * 64; c.n0 = (tt >> 4) * 128; }
    else if (t < 768) { const int tt = t - 256; c.src = P.in[19]; c.dst = (bf16_t*)(P.ws + WS_WM1); c.ldsrc = 4096; c.ldk = 1024; c.k0 = (tt & 15) * 64; c.n0 = (tt >> 4) * 128; }
    else { const int tt = t - 768; c.src = P.in[20]; c.dst = (bf16_t*)(P.ws + WS_WM2); c.ldsrc = 1024; c.ldk = 4096; c.k0 = (tt & 63) * 64; c.n0 = (tt >> 6) * 128; }
    return c; }
DI void mod_item(const Params& P, int item, float* sil) {
    const int tid = threadIdx.x, ns = item % 12, ksl = item / 12;
    if (tid < 144) { const int r = tid >> 4, kk = tid & 15; const float v = r < 8 ? P.in[1][r * 1024 + ksl * 16 + kk] : P.in[3][ksl * 16 + kk]; sil[tid] = v / (1.0f + expf(-v)); }
    const int n = ns * 512 + tid; const float* w = P.in[4] + (size_t)(ksl * 16) * 6144 + n; float wv[16];
#pragma unroll
    for (int kk = 0; kk < 16; ++kk) wv[kk] = w[(size_t)kk * 6144];
    __syncthreads();
    float acc[9];
#pragma unroll
    for (int r = 0; r < 9; ++r) acc[r] = 0.f;
#pragma unroll
    for (int kk = 0; kk < 16; ++kk)
#pragma unroll
        for (int r = 0; r < 9; ++r) acc[r] += sil[r * 16 + kk] * wv[kk];
    float* mod = (float*)(P.ws + WS_MOD); const float bias = ksl == 0 ? P.in[5][n] : 0.f;
#pragma unroll
    for (int r = 0; r < 9; ++r) atomicAdd(mod + r * 6144 + n, acc[r] + bias);
    __syncthreads();
}

DI void modnorm_rows(const float* src_lat, const float* src_ctx, int nrows, const float* g, const float* mod, int sh_off, int sc_off, bf16_t* dst) {
    const int wave = threadIdx.x >> 6, lane = threadIdx.x & 63; const int stride = gridDim.x * 8;
    int row = blockIdx.x * 8 + wave; f32x4 v[4], gg[4], sc[4], sh[4];
#pragma unroll
    for (int j = 0; j < 4; ++j) gg[j] = *(const f32x4*)(g + j * 256 + lane * 4);
#define MN_LOAD(r, V, SC, SH) do { const float* src_ = (r) < 16384 ? src_lat + (size_t)(r) * 1024 : src_ctx + (size_t)((r) - 16384) * 1024; const float* mr_ = mod + (size_t)((r) < 16384 ? ((r) >> 11) : 8) * 6144; \
        _Pragma("unroll") for (int j = 0; j < 4; ++j) { V[j] = __builtin_nontemporal_load((const f32x4*)(src_ + j * 256 + lane * 4)); SC[j] = *(const f32x4*)(mr_ + sc_off + j * 256 + lane * 4); SH[j] = *(const f32x4*)(mr_ + sh_off + j * 256 + lane * 4); } } while (0)
    if (row < nrows) MN_LOAD(row, v, sc, sh);
    for (; row < nrows; row += stride) {
        const int nrow = row + stride; f32x4 vn[4], scn[4], shn[4];
#pragma unroll
        for (int j = 0; j < 4; ++j) { vn[j] = v[j]; scn[j] = sc[j]; shn[j] = sh[j]; }
        if (nrow < nrows) MN_LOAD(nrow, vn, scn, shn);
        float ss = 0.f;
#pragma unroll
        for (int j = 0; j < 4; ++j) ss += v[j][0] * v[j][0] + v[j][1] * v[j][1] + v[j][2] * v[j][2] + v[j][3] * v[j][3];
#pragma unroll
        for (int off = 32; off >= 1; off >>= 1) ss += __shfl_xor(ss, off);
        const float rstd = rsqrtf(ss * (1.0f / 1024.0f) + 1e-6f);
#pragma unroll
        for (int j = 0; j < 4; ++j) { const int col = j * 256 + lane * 4;
            const f32x4 hh = v[j] * rstd * gg[j] * (sc[j] + 1.0f) + sh[j]; u32x2 w; w.x = pk2(hh[0], hh[1]); w.y = pk2(hh[2], hh[3]); *(u32x2*)(dst + (size_t)row * 1024 + col) = w; }
#pragma unroll
        for (int j = 0; j < 4; ++j) { v[j] = vn[j]; sc[j] = scn[j]; sh[j] = shn[j]; }
    }
#undef MN_LOAD
}

DI int frag_idx(int row, int k) { return ((((row >> 4) * 2 + (k >> 5)) * 64) + (((k & 15) >> 2) * 16 + (row & 15))) * 8 + ((k >> 4) & 1) * 4 + (k & 3); }
DI float silu_fast(float v) { return v * __builtin_amdgcn_rcpf(1.0f + __expf(-v)); }
DI void prep_phase(const Params& P, unsigned char* smem) {
    int tid_ = threadIdx.x; asm volatile("" : "+v"(tid_)); const int tid = tid_, half = tid >> 8, hid = tid & 255, lane = tid & 63, w4 = (tid >> 6) & 3, dir = half;
    const int r2 = half, r4a = 2 + half;
    unsigned char* hb = smem + half * 64256;
    bf16_t* sQ = (bf16_t*)hb; bf16_t* sK = sQ + 64 * 72; bf16_t* sV = sK + 64 * 72; bf16_t* sAn = sV + 64 * 72; bf16_t* sXt = sAn + 64 * 72; float* sAd = (float*)(hb + 55296); bf16_t* sD = (bf16_t*)(hb + 60416);
    float* sG = (float*)(hb + 63488); float* sBeta = sG + 64; float* sEG = sBeta + 64;
    const bf16_t* DQKV = (const bf16_t*)(P.ws + WS_DQKV); const float* AB = (const float*)(P.ws + WS_AB);
    float* sCW = (float*)(smem + 132096);
    for (int e = tid; e < 1152; e += NT) *(f32x4*)(sCW + e * 4) = *(const f32x4*)(P.in[11] + e * 4);
    const float r_alog = P.in[12][lane & 15], r_dtb = P.in[13][lane & 15];
    LBAR();
    u32x4 ra[3][3]; float rda = 0.f, rdb = 0.f;
#define PREP_LOAD(it) do { const int ci_ = (it) % 36, bh_ = (it) / 36, h_ = bh_ & 7, b_ = bh_ >> 3; const bool lat_ = ci_ >= 4; \
        const int sb_ = lat_ ? b_ * 2048 : 16384 + b_ * 256, sl_ = lat_ ? 2048 : 256, t0_ = lat_ ? (ci_ - 4) * 64 : ci_ * 64, t_ = t0_ + (tid >> 3); \
        _Pragma("unroll") for (int tap = 0; tap < 3; ++tap) { int tt = t_ + tap - 1; tt = tt < 0 ? 0 : (tt >= sl_ ? sl_ - 1 : tt); const bf16_t* pr = DQKV + (size_t)(sb_ + tt) * 1536 + h_ * 64 + (tid & 7) * 8; \
            _Pragma("unroll") for (int T = 0; T < 3; ++T) ra[T][tap] = *(const u32x4*)(pr + T * 512); } \
        if (w4 == r2) { const int tl_ = t0_ + (dir ? 63 - lane : lane); const float* ab_ = AB + (size_t)(sb_ + tl_) * 32; const int j_ = dir * 8 + h_; rda = ab_[j_]; rdb = ab_[16 + j_]; } } while (0)
    if ((int)blockIdx.x < 2304) PREP_LOAD((int)blockIdx.x);
    for (int item = blockIdx.x; item < 2304; item += gridDim.x) {
    const int ci = item % 36, bh = item / 36, h = bh & 7; const bool lat = ci >= 4;
    const int seqlen = lat ? 2048 : 256, t0 = lat ? (ci - 4) * 64 : ci * 64;
    unsigned char* rec = P.ws + WS_PREP + (size_t)item * 65536;
    bf16_t* Wp = (bf16_t*)(rec + 16384 + dir * 24576); bf16_t* Up = Wp + 4096; bf16_t* Ip = Up + 4096;
    float* sc = (float*)(P.ws + WS_SC) + (size_t)(item * 2 + dir) * 192;
    { const int c = tid >> 3, seg = tid & 7, t = t0 + c;
      float mk[3]; mk[0] = t - 1 >= 0 ? 1.0f : 0.0f; mk[1] = 1.0f; mk[2] = t + 1 < seqlen ? 1.0f : 0.0f;
#pragma unroll
      for (int T = 0; T < 3; ++T) {
          float y[8];
#pragma unroll
          for (int e = 0; e < 8; ++e) y[e] = 0.f;
          const float* cw = sCW + T * 512 + h * 64 + seg * 8;
#pragma unroll
          for (int tap = 0; tap < 3; ++tap) { const u32x4 a0 = ra[T][tap]; const float* w = cw + tap * 1536; const float m = mk[tap];
              const f32x4 w0 = *(const f32x4*)w * m, w1 = *(const f32x4*)(w + 4) * m;
              y[0] += w0[0] * lo16(a0.x); y[1] += w0[1] * hi16(a0.x); y[2] += w0[2] * lo16(a0.y); y[3] += w0[3] * hi16(a0.y); y[4] += w1[0] * lo16(a0.z); y[5] += w1[1] * hi16(a0.z); y[6] += w1[2] * lo16(a0.w); y[7] += w1[3] * hi16(a0.w); }
#pragma unroll
          for (int e = 0; e < 8; ++e) { y[e] = silu_fast(y[e]); if (T == 0 && !lat) y[e] = 0.f; }
          if (T < 2) { float ss = 0.f;
#pragma unroll
              for (int e = 0; e < 8; ++e) ss += y[e] * y[e];
              ss += __shfl_xor(ss, 1); ss += __shfl_xor(ss, 2); ss += __shfl_xor(ss, 4); const float sn = rsqrtf(ss + 1e-6f) * (T == 0 ? 0.125f : 1.0f);
#pragma unroll
              for (int e = 0; e < 8; ++e) y[e] *= sn; }
          u32x4 o0; o0.x = pk2(y[0], y[1]); o0.y = pk2(y[2], y[3]); o0.z = pk2(y[4], y[5]); o0.w = pk2(y[6], y[7]);
          const int toff = T * 64 * 72 + seg * 8;
          *(u32x4*)((bf16_t*)smem + toff + c * 72) = o0; *(u32x4*)((bf16_t*)(smem + 64256) + toff + (63 - c) * 72) = o0;
      } }
    if (w4 == r2) { const int c = lane; const int j = dir * 8 + h;
        const float xa = rda + __shfl(r_dtb, j); const float sp = xa > 20.f ? xa : log1pf(__expf(xa));
        float G = -__expf(__shfl(r_alog, j)) * sp; const float beta = __builtin_amdgcn_rcpf(1.0f + __expf(-rdb));
#pragma unroll
        for (int off = 1; off < 64; off <<= 1) { const float v = __shfl_up(G, off); if (lane >= off) G += v; }
        const float gl = __shfl(G, 63), eg = __expf(G);
        sG[c] = G; sBeta[c] = beta; sEG[c] = eg; sc[c] = eg; sc[64 + c] = __expf(gl - G); if (c == 0) sc[128] = __expf(gl); }
    LBAR();
    if (item + (int)gridDim.x < 2304) PREP_LOAD(item + (int)gridDim.x);
    { const int r16 = lane & 15, q = lane >> 4, mb = w4; f32x4 kk[4], kq[4];
#pragma unroll
      for (int nb = 0; nb < 4; ++nb) { kk[nb] = (f32x4){0.f, 0.f, 0.f, 0.f}; kq[nb] = (f32x4){0.f, 0.f, 0.f, 0.f}; }
#pragma unroll
      for (int ks = 0; ks < 2; ++ks) { const bf16x8 ak = *(const bf16x8*)(sK + (16 * mb + r16) * 72 + 32 * ks + 8 * q);
#pragma unroll
          for (int nb = 0; nb < 4; ++nb) { const bf16x8 bk = *(const bf16x8*)(sK + (16 * nb + r16) * 72 + 32 * ks + 8 * q), bq = *(const bf16x8*)(sQ + (16 * nb + r16) * 72 + 32 * ks + 8 * q);
              kk[nb] = MFMA16(ak, bk, kk[nb]); kq[nb] = MFMA16(ak, bq, kq[nb]); } }
#pragma unroll
      for (int nb = 0; nb < 4; ++nb) {
#pragma unroll
          for (int i = 0; i < 4; ++i) { const int ri = 16 * mb + 4 * q + i, cj = 16 * nb + r16; float a = 0.f;
              if (nb <= mb) a = cj < ri ? sBeta[ri] * __expf(fminf(sG[ri] - sG[cj], 0.f)) * kk[nb][i] : 0.f;
              sAn[ri * 72 + cj] = f2bf(-a); if (nb == mb) sAd[(mb * 16 + 4 * q + i) * 20 + r16] = a; }
          if (lat && nb < mb) { *(u32x2*)(Ip + frag_idx(16 * nb + r16, 16 * mb + 4 * q)) = (u32x2){0u, 0u}; }
          if (lat && nb >= mb) { const int ri = 16 * nb + r16; const float gi = sG[ri]; float iv[4];
#pragma unroll
              for (int i = 0; i < 4; ++i) { const int cj = 16 * mb + 4 * q + i; iv[i] = cj <= ri ? __expf(fminf(gi - sG[cj], 0.f)) * kq[nb][i] : 0.f; }
              u32x2 wv; wv.x = pk2(iv[0], iv[1]); wv.y = pk2(iv[2], iv[3]); *(u32x2*)(Ip + frag_idx(ri, 16 * mb + 4 * q)) = wv; } }
    }
    LBAR();
    if (w4 == r4a) { const int bb = lane >> 4, j = lane & 15; float x[16];
        typedef __attribute__((address_space(3))) const f32x4* lcf4; const lcf4 ad = (lcf4)(sAd + bb * 16 * 20);
        x[0] = j == 0 ? 1.0f : 0.0f;
#define DIAG_ROWS(lo, hi) do { f32x4 ar[(hi) - (lo)][4]; \
        _Pragma("unroll") for (int i = (lo); i < (hi); ++i) _Pragma("unroll") for (int k4 = 0; k4 < i; k4 += 4) ar[i - (lo)][k4 >> 2] = ad[i * 5 + (k4 >> 2)]; \
        _Pragma("unroll") for (int i = (lo); i < (hi); ++i) { float sv = i == j ? 1.0f : 0.0f; \
            _Pragma("unroll") for (int k4 = 0; k4 < i; k4 += 4) { const f32x4 a = ar[i - (lo)][k4 >> 2]; sv -= a[0] * x[k4]; if (k4 + 1 < i) sv -= a[1] * x[k4 + 1]; if (k4 + 2 < i) sv -= a[2] * x[k4 + 2]; if (k4 + 3 < i) sv -= a[3] * x[k4 + 3]; } \
            x[i] = sv; } } while (0)
        DIAG_ROWS(1, 9); DIAG_ROWS(9, 13); DIAG_ROWS(13, 16);
#undef DIAG_ROWS
#pragma unroll
        for (int i = 0; i < 16; ++i) sD[(bb * 16 + i) * 24 + j] = f2bf(x[i]);
    } else { const int rk = (w4 - (w4 > r4a ? 1 : 0)) * 64 + lane;
      if (dir == 0) { bf16_t* Qf = (bf16_t*)rec; bf16_t* KTf = Qf + 4096;
        for (int fid = rk; fid < 512; fid += 192) { const int fmb = fid >> 7, ks = (fid >> 6) & 1, lf = fid & 63, qf = lf >> 4, fr = lf & 15; const int row = 16 * fmb + fr, k0 = 32 * ks + 4 * qf;
            if (lat) { const u32x2 a = *(const u32x2*)(sQ + row * 72 + k0), bq = *(const u32x2*)(sQ + row * 72 + k0 + 16); u32x4 wv; wv.x = a.x; wv.y = a.y; wv.z = bq.x; wv.w = bq.y; *(u32x4*)(Qf + fid * 8) = wv; }
            u32x4 wv; const bf16_t* kc = sK + row;
            wv.x = (unsigned)kc[(k0 + 0) * 72] | ((unsigned)kc[(k0 + 1) * 72] << 16); wv.y = (unsigned)kc[(k0 + 2) * 72] | ((unsigned)kc[(k0 + 3) * 72] << 16);
            wv.z = (unsigned)kc[(k0 + 16) * 72] | ((unsigned)kc[(k0 + 17) * 72] << 16); wv.w = (unsigned)kc[(k0 + 18) * 72] | ((unsigned)kc[(k0 + 19) * 72] << 16);
            *(u32x4*)(KTf + fid * 8) = wv; } }
      for (int o = rk; o < 1024; o += 192) *(u32x4*)(sXt + (o >> 3) * 72 + (o & 7) * 8) = (u32x4){0u, 0u, 0u, 0u};
    }
    LBAR();
    { const int r16 = lane & 15, q = lane >> 4;
#pragma unroll
      for (int bb = 0; bb < 4; ++bb) {
          f32x4 be;
#pragma unroll
          for (int i = 0; i < 4; ++i) { const int ri = 16 * bb + 4 * q + i; be[i] = w4 < 2 ? sBeta[ri] * sEG[ri] : sBeta[ri]; }
          const u32x2 dq = *(const u32x2*)(sD + (bb * 16 + r16) * 24 + 4 * q); u32x4 dfr; dfr.x = dq.x; dfr.y = dq.y; dfr.z = 0u; dfr.w = 0u;
#pragma unroll
          for (int t = 0; t < 2; ++t) { const int n0 = 32 * w4 + 16 * t + r16; const bf16_t* rsrc = (w4 < 2 ? sK + n0 : sV + (n0 - 64)) + (16 * bb + 4 * q) * 72;
              f32x4 acc; acc[0] = be[0] * bf2f(rsrc[0]); acc[1] = be[1] * bf2f(rsrc[72]); acc[2] = be[2] * bf2f(rsrc[144]); acc[3] = be[3] * bf2f(rsrc[216]);
#pragma unroll
              for (int ks = 0; ks < (bb + 1) / 2; ++ks) acc = MFMA16(*(const bf16x8*)(sAn + (16 * bb + r16) * 72 + 32 * ks + 8 * q), *(const bf16x8*)(sXt + n0 * 72 + 32 * ks + 8 * q), acc);
              u32x4 yb; yb.x = pk2(acc[0], acc[1]); yb.y = pk2(acc[2], acc[3]); yb.z = 0u; yb.w = 0u;
              const f32x4 z = MFMA16(__builtin_bit_cast(bf16x8, dfr), __builtin_bit_cast(bf16x8, yb), ((f32x4){0.f, 0.f, 0.f, 0.f}));
              u32x2 zw; zw.x = pk2(z[0], z[1]); zw.y = pk2(z[2], z[3]);
              *(u32x2*)(sXt + n0 * 72 + 16 * bb + 4 * q) = zw;
              if (w4 >= 2) { const int vs = 2 * (w4 - 2) + t; *(u32x2*)(Up + ((vs * 4 + bb) * 64 + lane) * 4) = zw; } }
          asm volatile("s_waitcnt lgkmcnt(0)" ::: "memory");
      }
      if (w4 < 2) {
#pragma unroll
          for (int mb = 0; mb < 4; ++mb) { const bf16_t* xc = sXt + (32 * w4 + 4 * q) * 72 + 16 * mb + r16; u32x4 wv;
              wv.x = ((unsigned)xc[0] | ((unsigned)xc[72] << 16)) ^ 0x80008000u; wv.y = ((unsigned)xc[144] | ((unsigned)xc[216] << 16)) ^ 0x80008000u;
              wv.z = ((unsigned)xc[16 * 72] | ((unsigned)xc[17 * 72] << 16)) ^ 0x80008000u; wv.w = ((unsigned)xc[18 * 72] | ((unsigned)xc[19 * 72] << 16)) ^ 0x80008000u;
              *(u32x4*)(Wp + ((mb * 2 + w4) * 64 + lane) * 8) = wv; } }
    }
    LBAR();
    }
}

DI void qk_normrope(const Params& P) {
    bf16_t* AQ = (bf16_t*)(P.ws + WS_AQ); bf16_t* AKV = (bf16_t*)(P.ws + WS_AKV); const float* TAB = (const float*)(P.ws + WS_TAB);
    for (int task = blockIdx.x * NT + threadIdx.x; task < 131072 + 36864; task += gridDim.x * NT) {
        bf16_t* ptr; const float* g; bool rope; int pos; float extra;
        if (task < 131072) { const int row = task >> 3, hd = task & 7; ptr = AQ + (size_t)row * 512 + hd * 64; g = P.in[8]; rope = true; pos = row & 2047; extra = 0.125f * LOG2E; }
        else { const int t2 = task - 131072, row = t2 >> 1, hd = t2 & 1; ptr = AKV + (size_t)row * 256 + hd * 64; g = P.in[9]; rope = row < 16384; pos = row & 2047; extra = 1.0f; }
        float v[64]; float ss = 0.f;
#pragma unroll
        for (int j = 0; j < 8; ++j) { const u32x4 a = *(const u32x4*)(ptr + j * 8); v[j * 8 + 0] = lo16(a.x); v[j * 8 + 1] = hi16(a.x); v[j * 8 + 2] = lo16(a.y); v[j * 8 + 3] = hi16(a.y); v[j * 8 + 4] = lo16(a.z); v[j * 8 + 5] = hi16(a.z); v[j * 8 + 6] = lo16(a.w); v[j * 8 + 7] = hi16(a.w); }
#pragma unroll
        for (int d = 0; d < 64; ++d) ss += v[d] * v[d];
        const float rs = rsqrtf(ss * (1.0f / 64.0f) + 1e-6f);
#pragma unroll
        for (int d = 0; d < 64; ++d) v[d] = v[d] * rs * g[d];
        if (rope) { const float* tr = TAB + (size_t)(pos >> 6) * 32; const float* tc = TAB + (size_t)(pos & 63) * 32;
#pragma unroll
            for (int f = 0; f < 16; ++f) { const float c1 = tr[2 * f], s1 = tr[2 * f + 1], c2 = tc[2 * f], s2 = tc[2 * f + 1];
                const float a1 = v[f], a2 = v[16 + f], b1 = v[32 + f], b2 = v[48 + f];
                v[f] = a1 * c1 - a2 * s1; v[16 + f] = a1 * s1 + a2 * c1; v[32 + f] = b1 * c2 - b2 * s2; v[48 + f] = b1 * s2 + b2 * c2; } }
#pragma unroll
        for (int j = 0; j < 8; ++j) { u32x4 w; w.x = pk2(v[j * 8] * extra, v[j * 8 + 1] * extra); w.y = pk2(v[j * 8 + 2] * extra, v[j * 8 + 3] * extra); w.z = pk2(v[j * 8 + 4] * extra, v[j * 8 + 5] * extra); w.w = pk2(v[j * 8 + 6] * extra, v[j * 8 + 7] * extra);
            *(u32x4*)(ptr + j * 8) = w; }
    }
}

#define SC_LAS __attribute__((address_space(3)))
DI int scan_chunk(int dir, int p) { return dir == 0 ? p : (p < 4 ? 3 - p : 39 - p); }
DI void scan_block(const Params& P, int sb, unsigned char* smem) {
    int tid_ = threadIdx.x; asm volatile("" : "+v"(tid_)); const int tid = tid_, lane = tid & 63, r16 = lane & 15, q = lane >> 4;
    const int w = __builtin_amdgcn_readfirstlane(tid >> 6), pair = sb >> 1, dir = sb & 1; const int b = pair >> 3, h = pair & 7;
    SC_LAS unsigned char* L = (SC_LAS unsigned char*)smem;
    const unsigned char* prep = P.ws + WS_PREP + (size_t)pair * 36 * 65536;
    __syncthreads();
    if (w >= 4) {
        const int m = w - 4; const int moff = m == 0 ? 16384 + dir * 24576 : (m == 1 ? 0 : (m == 2 ? 32768 + dir * 24576 : 8192));
#define SCAN_DMA(pp) do { const unsigned char* src_ = prep + (size_t)scan_chunk(dir, (pp)) * 65536 + moff + lane * 16; SC_LAS unsigned char* dst_ = L + ((pp) % 3) * 32768 + m * 8192; \
        _Pragma("unroll") for (int i_ = 0; i_ < 8; ++i_) __builtin_amdgcn_global_load_lds((const unsigned*)(src_ + i_ * 1024), (SC_LAS unsigned*)(dst_ + i_ * 1024), 16, 0, 0); } while (0)
        SCAN_DMA(0); SCAN_DMA(1);
        for (int p = 0; p < 36; ++p) {
            if (p + 1 < 36) asm volatile("s_waitcnt vmcnt(8)" ::: "memory"); else asm volatile("s_waitcnt vmcnt(0)" ::: "memory");
            __builtin_amdgcn_s_barrier();
            if (p + 2 < 36) SCAN_DMA(p + 2);
        }
#undef SCAN_DMA
    } else {
        const int vs = w; bf16_t* Oout = (bf16_t*)(P.ws + (dir ? WS_OB : WS_OF)); const float* scb = (const float*)(P.ws + WS_SC) + (size_t)pair * 36 * 2 * 192 + dir * 192;
#define SCAN_LDREG(pp, Ur, Eg, Tl, Egl) do { const int ci_ = scan_chunk(dir, (pp)); const bf16_t* Up_ = (const bf16_t*)(prep + (size_t)ci_ * 65536 + 16384 + dir * 24576 + 8192); const float* sc_ = scb + (size_t)ci_ * 384; \
        _Pragma("unroll") for (int mb_ = 0; mb_ < 4; ++mb_) { Ur[mb_] = *(const u32x2*)(Up_ + ((vs * 4 + mb_) * 64 + lane) * 4); Eg[mb_] = *(const f32x4*)(sc_ + 16 * mb_ + 4 * q); Tl[mb_] = *(const f32x4*)(sc_ + 64 + 16 * mb_ + 4 * q); } \
        Egl = sc_[128]; } while (0)
        f32x4 S[4];
#pragma unroll
        for (int r = 0; r < 4; ++r) S[r] = (f32x4){0.f, 0.f, 0.f, 0.f};
        u32x2 Uc[4]; f32x4 Egc[4], Tlc[4]; float Eglc; u32x2 opk[4]; int otb = -1;
#pragma unroll
        for (int mb = 0; mb < 4; ++mb) { opk[mb].x = 0u; opk[mb].y = 0u; }
#define SCAN_OSTORE() do { _Pragma("unroll") for (int mb_ = 0; mb_ < 4; ++mb_) { const int cp_ = 16 * mb_ + 4 * q; bf16_t* ob_ = Oout + (size_t)otb * 512 + h * 64 + 16 * vs + r16; const int st_ = dir ? -512 : 512; ob_ += (dir ? 63 - cp_ : cp_) * 512; \
        ob_[0] = (bf16_t)(opk[mb_].x & 0xffffu); ob_[st_] = (bf16_t)(opk[mb_].x >> 16); ob_[2 * st_] = (bf16_t)(opk[mb_].y & 0xffffu); ob_[3 * st_] = (bf16_t)(opk[mb_].y >> 16); } } while (0)
        SCAN_LDREG(0, Uc, Egc, Tlc, Eglc);
        for (int p = 0; p < 36; ++p) {
            asm volatile("s_waitcnt vmcnt(0)" ::: "memory"); __builtin_amdgcn_s_barrier(); asm volatile("" ::: "memory");
            if (otb >= 0) { SCAN_OSTORE(); otb = -1; }
            u32x2 Un[4]; f32x4 Egn[4], Tln[4]; float Egln = 0.f;
#pragma unroll
            for (int mb = 0; mb < 4; ++mb) { Un[mb] = Uc[mb]; Egn[mb] = Egc[mb]; Tln[mb] = Tlc[mb]; }
            if (p + 1 < 36) { SCAN_LDREG(p + 1, Un, Egn, Tln, Egln); }
            const int ci = scan_chunk(dir, p); const bool lat = ci >= 4;
            const SC_LAS unsigned char* B0 = L + (p % 3) * 32768;
#define SCAN_FRAG(m, idx) (*(const SC_LAS bf16x8*)(B0 + (m) * 8192 + (idx) * 16))
            bf16x8 Sb[2]; Sb[0] = pack8(S[0], S[1]); Sb[1] = pack8(S[2], S[3]);
            f32x4 u[4];
#pragma unroll
            for (int mb = 0; mb < 4; ++mb) { u[mb][0] = lo16(Uc[mb].x); u[mb][1] = hi16(Uc[mb].x); u[mb][2] = lo16(Uc[mb].y); u[mb][3] = hi16(Uc[mb].y); }
#pragma unroll
            for (int mb = 0; mb < 4; ++mb)
#pragma unroll
                for (int ks = 0; ks < 2; ++ks) u[mb] = MFMA16(SCAN_FRAG(0, (mb * 2 + ks) * 64 + lane), Sb[ks], u[mb]);
            if (lat) {
                f32x4 o[4];
#pragma unroll
                for (int mb = 0; mb < 4; ++mb) { o[mb] = (f32x4){0.f, 0.f, 0.f, 0.f};
#pragma unroll
                    for (int ks = 0; ks < 2; ++ks) { const int qi = dir ? (((3 - mb) * 2 + ks) * 64 + (lane ^ 15)) : ((mb * 2 + ks) * 64 + lane); o[mb] = MFMA16(SCAN_FRAG(1, qi), Sb[ks], o[mb]); }
                    o[mb] = o[mb] * Egc[mb]; }
                bf16x8 ub[2]; ub[0] = pack8(u[0], u[1]); ub[1] = pack8(u[2], u[3]);
#pragma unroll
                for (int mb = 0; mb < 4; ++mb)
#pragma unroll
                    for (int ks = 0; ks < 2; ++ks) o[mb] = MFMA16(SCAN_FRAG(2, (mb * 2 + ks) * 64 + lane), ub[ks], o[mb]);
                otb = b * 2048 + (ci - 4) * 64;
#pragma unroll
                for (int mb = 0; mb < 4; ++mb) { opk[mb].x = pk2(o[mb][0], o[mb][1]); opk[mb].y = pk2(o[mb][2], o[mb][3]); }
            }
            f32x4 u2[4];
#pragma unroll
            for (int mb = 0; mb < 4; ++mb) u2[mb] = u[mb] * Tlc[mb];
            bf16x8 ub2[2]; int kl;
            if (dir == 0) { ub2[0] = pack8(u2[0], u2[1]); ub2[1] = pack8(u2[2], u2[3]); kl = lane; }
            else { ub2[0] = pack8r(u2[3], u2[2]); ub2[1] = pack8r(u2[1], u2[0]); kl = (3 - q) * 16 + r16; }
#pragma unroll
            for (int r = 0; r < 4; ++r) { S[r] = S[r] * Eglc;
#pragma unroll
                for (int ks = 0; ks < 2; ++ks) S[r] = MFMA16(SCAN_FRAG(3, (r * 2 + ks) * 64 + kl), ub2[ks], S[r]); }
#pragma unroll
            for (int mb = 0; mb < 4; ++mb) { Uc[mb] = Un[mb]; Egc[mb] = Egn[mb]; Tlc[mb] = Tln[mb]; }
            Eglc = Egln;
        }
        if (otb >= 0) { SCAN_OSTORE(); }
#undef SCAN_OSTORE
#undef SCAN_FRAG
#undef SCAN_LDREG
    }
    asm volatile("s_waitcnt vmcnt(0) lgkmcnt(0)" ::: "memory"); __syncthreads();
}

DI void attn_phase(const Params& P, unsigned char* smem, unsigned* ctr, volatile int* sItem) {
    int tid_ = threadIdx.x; asm volatile("" : "+v"(tid_)); const int tid = tid_, w = tid >> 6, lane = tid & 63, r16 = lane & 15, q = lane >> 4;
    bf16_t* AQ = (bf16_t*)(P.ws + WS_AQ); const bf16_t* AKV = (const bf16_t*)(P.ws + WS_AKV);
    bf16_t* sK = (bf16_t*)smem; bf16_t* sVt = sK + 2 * 64 * 72;
    const int key = tid >> 3, seg = tid & 7;
    LBAR(); if (tid == 0) sItem[0] = (int)atomicAdd(ctr, 1u); LBAR();
    int item = sItem[0]; if (item >= 1024) return;
    bf16x8 Qb[2]; u32x4 kreg, vreg;
#define ATT_FIRST(it, Q0, Q1) do { const int b_ = (it) >> 7, qb_ = ((it) >> 3) & 15, hd_ = (it) & 7, q0_ = qb_ * 128, lo_ = q0_ - 128 < 0 ? 0 : q0_ - 128; \
        const bf16_t* qr_ = AQ + (size_t)(b_ * 2048 + q0_ + 16 * w + r16) * 512 + hd_ * 64; Q0 = *(const bf16x8*)(qr_ + 8 * q); Q1 = *(const bf16x8*)(qr_ + 32 + 8 * q); \
        const bf16_t* kp_ = AKV + (size_t)(b_ * 2048 + lo_ + key) * 256 + (hd_ >> 2) * 64 + seg * 8; kreg = *(const u32x4*)kp_; vreg = *(const u32x4*)(kp_ + 128); } while (0)
    ATT_FIRST(item, Qb[0], Qb[1]);
    for (;;) {
        if (tid == 0) sItem[1] = (int)atomicAdd(ctr, 1u);
        const int b = item >> 7, qb = (item >> 3) & 15, head = item & 7, g = head >> 2, q0 = qb * 128;
        const int qpos = q0 + 16 * w + r16; bf16_t* qrow = AQ + (size_t)(b * 2048 + qpos) * 512 + head * 64;
        float m = P.in[10][head] * LOG2E, l = q == 0 ? 1.0f : 0.0f; f32x4 O[4];
#pragma unroll
        for (int mb = 0; mb < 4; ++mb) O[mb] = (f32x4){0.f, 0.f, 0.f, 0.f};
        const int lo = q0 - 128 < 0 ? 0 : q0 - 128, hi = q0 + 256 > 2048 ? 2048 : q0 + 256, nloc = (hi - lo) >> 6, ntile = nloc + 4;
        int nxt = 1024; bf16x8 Qn[2]; Qn[0] = Qb[0]; Qn[1] = Qb[1];
        for (int j = 0; j < ntile; ++j) {
            const int buf = j & 1; bf16_t* bK = sK + buf * 64 * 72; bf16_t* bV = sVt + buf * 64 * 76;
            *(u32x4*)(bK + key * 72 + seg * 8) = kreg;
            { bf16_t* vp = bV + (seg * 8) * 76 + key; vp[0] = (bf16_t)(vreg.x & 0xffffu); vp[76] = (bf16_t)(vreg.x >> 16); vp[152] = (bf16_t)(vreg.y & 0xffffu); vp[228] = (bf16_t)(vreg.y >> 16);
              vp[304] = (bf16_t)(vreg.z & 0xffffu); vp[380] = (bf16_t)(vreg.z >> 16); vp[456] = (bf16_t)(vreg.w & 0xffffu); vp[532] = (bf16_t)(vreg.w >> 16); }
            LBAR();
            if (j == 0) nxt = sItem[1];
            if (j + 1 < ntile) { const int jn = j + 1; const int rb = jn < nloc ? b * 2048 + lo + 64 * jn : 16384 + b * 256 + 64 * (jn - nloc);
                const bf16_t* kp = AKV + (size_t)(rb + key) * 256 + g * 64 + seg * 8; kreg = *(const u32x4*)kp; vreg = *(const u32x4*)(kp + 128); }
            else if (nxt < 1024) { ATT_FIRST(nxt, Qn[0], Qn[1]); }
            const int kt0 = lo + 64 * j, qw0 = q0 + 16 * w;
            if (j < nloc && (kt0 + 63 < qw0 - 128 || kt0 > qw0 + 15 + 128)) continue;
            f32x4 s[4];
#pragma unroll
            for (int mb = 0; mb < 4; ++mb) { s[mb] = (f32x4){0.f, 0.f, 0.f, 0.f};
#pragma unroll
                for (int ks = 0; ks < 2; ++ks) s[mb] = MFMA16(*(const bf16x8*)(bK + (16 * mb + r16) * 72 + 32 * ks + 8 * q), Qb[ks], s[mb]); }
            if (j < nloc && (kt0 < qw0 + 15 - 128 || kt0 + 63 > qw0 + 128)) { const int kp0 = lo + 64 * j + 4 * q;
#pragma unroll
                for (int mb = 0; mb < 4; ++mb)
#pragma unroll
                    for (int i = 0; i < 4; ++i) { const int d = qpos - (kp0 + 16 * mb + i); if (d > 128 || d < -128) s[mb][i] = -1e30f; } }
            float tmax = -1e30f;
#pragma unroll
            for (int mb = 0; mb < 4; ++mb)
#pragma unroll
                for (int i = 0; i < 4; ++i) tmax = fmaxf(tmax, s[mb][i]);
            tmax = fmaxf(tmax, __shfl_xor(tmax, 16)); tmax = fmaxf(tmax, __shfl_xor(tmax, 32));
            const float mnew = fmaxf(m, tmax), alpha = __builtin_amdgcn_exp2f(m - mnew); m = mnew; float ls = 0.f;
#pragma unroll
            for (int mb = 0; mb < 4; ++mb)
#pragma unroll
                for (int i = 0; i < 4; ++i) { const float pv = __builtin_amdgcn_exp2f(s[mb][i] - mnew); s[mb][i] = pv; ls += pv; }
            l = l * alpha + ls;
#pragma unroll
            for (int mb = 0; mb < 4; ++mb) O[mb] = O[mb] * alpha;
            bf16x8 pb[2]; pb[0] = pack8(s[0], s[1]); pb[1] = pack8(s[2], s[3]);
#pragma unroll
            for (int mb = 0; mb < 4; ++mb)
#pragma unroll
                for (int ks = 0; ks < 2; ++ks) { const bf16_t* vp = bV + (16 * mb + r16) * 76 + 32 * ks + 4 * q; const u32x2 a = *(const u32x2*)vp, c2 = *(const u32x2*)(vp + 16); u32x4 av; av.x = a.x; av.y = a.y; av.z = c2.x; av.w = c2.y;
                    O[mb] = MFMA16(__builtin_bit_cast(bf16x8, av), pb[ks], O[mb]); }
        }
        l += __shfl_xor(l, 16); l += __shfl_xor(l, 32); const float inv = 1.0f / l;
#pragma unroll
        for (int mb = 0; mb < 4; ++mb) { u32x2 wv; wv.x = pk2(O[mb][0] * inv, O[mb][1] * inv); wv.y = pk2(O[mb][2] * inv, O[mb][3] * inv); *(u32x2*)(qrow + 16 * mb + 4 * q) = wv; }
        LBAR();
        if (nxt >= 1024) break;
        item = nxt; Qb[0] = Qn[0]; Qb[1] = Qn[1];
    }
#undef ATT_FIRST
}

DI void combine_yd(const Params& P) {
    const bf16_t* OF = (const bf16_t*)(P.ws + WS_OF); const bf16_t* OB = (const bf16_t*)(P.ws + WS_OB); const bf16_t* DZ = (const bf16_t*)(P.ws + WS_DZ); bf16_t* YD = (bf16_t*)(P.ws + WS_YD); const float* g = P.in[14];
    const int stride = gridDim.x * NT; int task = blockIdx.x * NT + threadIdx.x;
    u32x4 ar[2], cr[2], zr[2]; float gl[16];
#pragma unroll
    for (int e = 0; e < 16; ++e) gl[e] = g[(task & 3) * 16 + e];
    if (task < 524288) { const size_t off = (size_t)task * 16; ar[0] = *(const u32x4*)(OF + off); ar[1] = *(const u32x4*)(OF + off + 8); cr[0] = *(const u32x4*)(OB + off); cr[1] = *(const u32x4*)(OB + off + 8); zr[0] = *(const u32x4*)(DZ + off); zr[1] = *(const u32x4*)(DZ + off + 8); }
    for (; task < 524288; task += stride) {
        const size_t off = (size_t)task * 16; float v[16]; float ss = 0.f; u32x4 an[2], cn[2], zn[2];
#pragma unroll
        for (int j = 0; j < 2; ++j) { an[j] = ar[j]; cn[j] = cr[j]; zn[j] = zr[j]; }
        if (task + stride < 524288) { const size_t o2 = (size_t)(task + stride) * 16;
            an[0] = *(const u32x4*)(OF + o2); an[1] = *(const u32x4*)(OF + o2 + 8); cn[0] = *(const u32x4*)(OB + o2); cn[1] = *(const u32x4*)(OB + o2 + 8); zn[0] = *(const u32x4*)(DZ + o2); zn[1] = *(const u32x4*)(DZ + o2 + 8); }
#pragma unroll
        for (int j = 0; j < 2; ++j) { const u32x4 a = ar[j], c = cr[j];
            v[j * 8 + 0] = lo16(a.x) + lo16(c.x); v[j * 8 + 1] = hi16(a.x) + hi16(c.x); v[j * 8 + 2] = lo16(a.y) + lo16(c.y); v[j * 8 + 3] = hi16(a.y) + hi16(c.y);
            v[j * 8 + 4] = lo16(a.z) + lo16(c.z); v[j * 8 + 5] = hi16(a.z) + hi16(c.z); v[j * 8 + 6] = lo16(a.w) + lo16(c.w); v[j * 8 + 7] = hi16(a.w) + hi16(c.w); }
#pragma unroll
        for (int d = 0; d < 16; ++d) ss += v[d] * v[d];
        ss += __shfl_xor(ss, 1); ss += __shfl_xor(ss, 2);
        const float rs = rsqrtf(ss * (1.0f / 64.0f) + 1e-6f);
#pragma unroll
        for (int j = 0; j < 2; ++j) { const u32x4 z = zr[j]; float y[8];
            y[0] = silu(lo16(z.x)); y[1] = silu(hi16(z.x)); y[2] = silu(lo16(z.y)); y[3] = silu(hi16(z.y)); y[4] = silu(lo16(z.z)); y[5] = silu(hi16(z.z)); y[6] = silu(lo16(z.w)); y[7] = silu(hi16(z.w));
#pragma unroll
            for (int e = 0; e < 8; ++e) y[e] *= v[j * 8 + e] * rs * gl[j * 8 + e];
            u32x4 wv; wv.x = pk2(y[0], y[1]); wv.y = pk2(y[2], y[3]); wv.z = pk2(y[4], y[5]); wv.w = pk2(y[6], y[7]); *(u32x4*)(YD + off + j * 8) = wv; }
#pragma unroll
        for (int j = 0; j < 2; ++j) { ar[j] = an[j]; cr[j] = cn[j]; zr[j] = zn[j]; }
    }
}


DI void dadb_stage(const Params& P, unsigned char* smem) {
    const bf16_t* B = (const bf16_t*)(P.ws + WS_WIN) + (size_t)4864 * 1024;
#pragma unroll
    for (int i = 0; i < 8; ++i) { const int p = threadIdx.x + 512 * i, row = p >> 7, c8 = p & 127; *(u32x4*)((bf16_t*)smem + row * 1032 + c8 * 8) = *(const u32x4*)(B + (size_t)row * 1024 + c8 * 8); }
}
DI void dadb_task(const Params& P, int task, int lane, const unsigned char* smem) {
    const int r16 = lane & 15, q = lane >> 4; const bf16_t* A = (const bf16_t*)(P.ws + WS_H) + (size_t)(task * 16 + r16) * 1024 + 8 * q; const bf16_t* B = (const bf16_t*)smem + r16 * 1032 + 8 * q;
    f32x4 acc0 = (f32x4){0.f, 0.f, 0.f, 0.f}, acc1 = acc0; bf16x8 a[32];
#pragma unroll
    for (int ks = 0; ks < 32; ++ks) a[ks] = *(const bf16x8*)(A + 32 * ks);
    __builtin_amdgcn_sched_barrier(0);
#pragma unroll
    for (int ks = 0; ks < 32; ++ks) { acc0 = MFMA16(a[ks], *(const bf16x8*)(B + 32 * ks), acc0); acc1 = MFMA16(a[ks], *(const bf16x8*)(B + 16 * 1032 + 32 * ks), acc1); }
    float* AB = (float*)(P.ws + WS_AB) + (size_t)(task * 16 + 4 * q) * 32 + r16;
#pragma unroll
    for (int i = 0; i < 4; ++i) { AB[i * 32] = acc0[i]; AB[i * 32 + 16] = acc1[i]; }
}

#define XB_TMO      128
#define XB_XCNT(j)  (256  + 64 * (j))
#define XB_XSUB(j)  (1280 + 64 * (j))
#define XB_XGEN(j)  (2304 + 64 * (j))
#define XB_TOP      3328
#define XB_TOPGEN   3392
#define XCD_BAR_WORDS 3456
#define XB_SPIN_CAP (1u << 18)
#define LASB __attribute__((address_space(3)))
DI unsigned xb_ld(unsigned* p)              { return __hip_atomic_load(p, __ATOMIC_RELAXED, __HIP_MEMORY_SCOPE_AGENT); }
DI unsigned xb_add(unsigned* p, unsigned v) { return __hip_atomic_fetch_add(p, v, __ATOMIC_RELAXED, __HIP_MEMORY_SCOPE_AGENT); }
DI unsigned xb_xcc_id() { return (unsigned)__builtin_amdgcn_s_getreg((3 << 11) | 20) & 0xFu; }
#define XB_SPIN(cond, bar) do { unsigned _sp = 0; while (cond) { __builtin_amdgcn_s_sleep(1); \
    if ((++_sp & 255u) == 0u) { if (xb_ld(&(bar)[XB_TMO])) break; if (_sp > XB_SPIN_CAP) { atomicAdd(&(bar)[XB_TMO], 1u); break; } } } } while (0)
struct XcdBarrier { unsigned* bar; unsigned x; volatile LASB unsigned* st; };
DI XcdBarrier xcd_barrier_post(unsigned* bar, volatile LASB unsigned* st) {
    XcdBarrier b; b.bar = bar; b.x = xb_xcc_id(); b.st = st;
    if (threadIdx.x == 0) (void)xb_add(&bar[XB_XCNT(b.x)], 1u);
    return b;
}
DI void xcd_barrier_complete(unsigned* bar, unsigned x, unsigned& nloc, unsigned& nx) {
    const unsigned G = gridDim.x * gridDim.y * gridDim.z;
    unsigned sum, cnt, mine, sp = 0u;
    for (;;) {
        sum = 0u; cnt = 0u; mine = 0u;
#pragma unroll
        for (unsigned j = 0; j < 16; ++j) { const unsigned c = xb_ld(&bar[XB_XCNT(j)]); sum += c; cnt += (c > 0u) ? 1u : 0u; mine = (j == x) ? c : mine; }
        if (sum == G) break;
        __builtin_amdgcn_s_sleep(1);
        if ((++sp & 255u) == 0u) { if (xb_ld(&bar[XB_TMO])) break; if (sp > XB_SPIN_CAP) { atomicAdd(&bar[XB_TMO], 1u); break; } }
    }
    nloc = mine > 0u ? mine : 1u; nx = cnt > 0u ? cnt : 1u;
}
DI void xcd_barrier(const XcdBarrier& b) {
    asm volatile("s_waitcnt vmcnt(0)" ::: "memory");
    __syncthreads();
    if (threadIdx.x == 0) {
        unsigned* bar = b.bar;
        __builtin_amdgcn_s_waitcnt(0);
        unsigned nloc = b.st[0], nx = b.st[1];
        if (nloc == 0u) { xcd_barrier_complete(bar, b.x, nloc, nx); b.st[0] = nloc; b.st[1] = nx; }
        const unsigned old = xb_add(&bar[XB_XSUB(b.x)], 1u);
        const unsigned gen = old / nloc;
        if (old + 1u == (gen + 1u) * nloc) {
            __builtin_amdgcn_fence(__ATOMIC_RELEASE, "agent");
            asm volatile("s_waitcnt vmcnt(0)" ::: "memory");
            const unsigned og = xb_add(&bar[XB_TOP], 1u);
            const unsigned tg = og / nx;
            if (og + 1u == (tg + 1u) * nx) xb_add(&bar[XB_TOPGEN], 1u);
            else XB_SPIN(xb_ld(&bar[XB_TOPGEN]) == tg, bar);
            __builtin_amdgcn_fence(__ATOMIC_ACQUIRE, "agent");
            xb_add(&bar[XB_XGEN(b.x)], 1u);
            asm volatile("s_waitcnt vmcnt(0)" ::: "memory");
        } else {
            XB_SPIN(xb_ld(&bar[XB_XGEN(b.x)]) == gen, bar);
            __builtin_amdgcn_fence(__ATOMIC_ACQUIRE, "agent");
            asm volatile("s_waitcnt vmcnt(0)" ::: "memory");
        }
    }
    __syncthreads();
}

__global__ void __launch_bounds__(NT) fwd(Params P) {
    extern __shared__ __attribute__((aligned(16))) unsigned char lds[];
    cg::grid_group grid = cg::this_grid();
    const int tid = threadIdx.x, bid = blockIdx.x, G = gridDim.x;
    unsigned char* ws = P.ws;
    volatile int* sItem = (volatile int*)(lds + 131072);
    if (tid < 8) ((volatile LASB unsigned*)(lds + 131072 + 16))[tid] = 0u;
    __syncthreads();
    XcdBarrier xbar = xcd_barrier_post((unsigned*)(ws + 4096), (volatile LASB unsigned*)(lds + 131072 + 16));
    if (P.ws == nullptr) grid.sync();
#define GRID_SYNC() xcd_barrier(xbar)
    pg8::EpiP ep; ep.AQ = (bf16_t*)(ws + WS_AQ); ep.AKV = (bf16_t*)(ws + WS_AKV); ep.DQKV = (bf16_t*)(ws + WS_DQKV); ep.DZ = (bf16_t*)(ws + WS_DZ); ep.GATES = (bf16_t*)P.out; ep.Y = (bf16_t*)(ws + WS_Y);
    ep.AB = (float*)(ws + WS_AB); ep.x = P.in[0]; ep.mod = (const float*)(ws + WS_MOD); ep.out = P.out; ep.ACT = (bf16_t*)(ws + WS_ACT); ep.g2 = P.in[18]; ep.H2 = (bf16_t*)(ws + WS_H2); ep.rowsq = (float*)(ws + WS_ROWSQ); ep.bias = (const float*)(ws + WS_BIAS);
    PG8_LAS unsigned char* glds = (PG8_LAS unsigned char*)lds;

#ifdef PROBE_SYNC
    for (int i = 0; i < PROBE_SYNC; ++i) GRID_SYNC();
#endif
    { float* tile = (float*)lds;
#ifndef NO_P0
      for (int it = bid; it < 768; it += G) mod_item(P, it, tile);
#define DEC_WIN(t) dec_win(P, (t))
      __syncthreads(); CONV_TILES(bid, G, 624, DEC_WIN, tile, NO_HOOK);
      const int gt = bid * NT + tid; if (gt < 1024) { const int pos = gt >> 4, f = gt & 15; const float ang = (float)pos * powf(10000.0f, -(float)f / 16.0f); float* TAB = (float*)(ws + WS_TAB); TAB[2 * gt] = cosf(ang); TAB[2 * gt + 1] = sinf(ang); }
#endif
    }
    GRID_SYNC();
#ifndef NO_P1
#ifdef PROBE_P1
    for (int rep = 0; rep < PROBE_P1; ++rep)
#endif
    modnorm_rows(P.in[0], P.in[2], 18432, P.in[6], (const float*)(ws + WS_MOD), 0, 1024, (bf16_t*)(ws + WS_H));
#endif
    GRID_SYNC();
#ifndef NO_P2
#ifdef PROBE_G1
    for (int rep = 0; rep < PROBE_G1; ++rep)
#endif
    { pg8::Gemm g{(const bf16_t*)(ws + WS_H), (const bf16_t*)(ws + WS_WIN), 18432, 4864, 1024}; pg8::SchedIn S{G, bid}; pg8::Epi<0> E{ep}; pg8::gemm_phase<pg8::Epi<0>, pg8::SchedIn, GEMM_ALIGN, GEMM_SP2>(glds, g, S, E); }
    { dadb_stage(P, lds); __syncthreads();
    for (int task = (tid >> 6) * G + bid; task < 1152; task += G * 8) dadb_task(P, task, tid & 63, lds); }
#endif
    GRID_SYNC();
#ifndef NO_P4A
#ifdef PROBE_PREP
    for (int rep = 0; rep < PROBE_PREP; ++rep)
#endif
    prep_phase(P, lds);
#endif
#ifndef NO_P4B
    qk_normrope(P);
#endif
    GRID_SYNC();
#ifndef NO_P5A
#ifdef PROBE_SCAN
    for (int rep = 0; rep < PROBE_SCAN; ++rep)
#endif
    if (bid < 128) scan_block(P, bid, lds);
#endif
#ifndef NO_P5B
    attn_phase(P, lds, (unsigned*)(ws + WS_CTL), sItem);
#endif
    GRID_SYNC();
#ifndef NO_P6
#ifdef PROBE_EW
    for (int rep = 0; rep < PROBE_EW; ++rep) {
#else
    {
#endif
    combine_yd(P);
    { float* tile = (float*)lds;
#define DEC_REST(t) dec_rest(P, (t))
      __syncthreads(); CONV_TILES(bid, G, 1280, DEC_REST, tile, BIAS_HOOK); }
    }
#endif
    GRID_SYNC();
#ifndef NO_P7
#ifdef PROBE_G23
    for (int rep = 0; rep < PROBE_G23; ++rep)
#endif
    { pg8::Gemm g{(const bf16_t*)(ws + WS_AQ), (const bf16_t*)(ws + WS_WBR), 16384, 1024, 512, 16, 8, (size_t)16 * MiB - 1024, (size_t)1024 * 512 * 2 - 1024}; pg8::SchedStd S{4, 256, G, bid}; pg8::Epi<1> E{ep}; pg8::gemm_phase<pg8::Epi<1>, pg8::SchedStd, GEMM_ALIGN, GEMM_SP2>(glds, g, S, E); }
#endif
    GRID_SYNC();
#ifndef NO_P8
#ifdef PROBE_G23
    for (int rep = 0; rep < PROBE_G23; ++rep)
#endif
    { pg8::Gemm g{(const bf16_t*)(ws + WS_Y), (const bf16_t*)(ws + WS_WOUT), 16384, 1024, 1024}; pg8::SchedStd S{4, 256, G, bid}; pg8::Epi<2> E{ep}; pg8::gemm_phase<pg8::Epi<2>, pg8::SchedStd, GEMM_ALIGN, GEMM_SP2>(glds, g, S, E); }
#endif
    GRID_SYNC();
#ifndef NO_P10
#ifdef PROBE_G4
    for (int rep = 0; rep < PROBE_G4; ++rep)
#endif
    { pg8::Gemm g{(const bf16_t*)(ws + WS_H2), (const bf16_t*)(ws + WS_WM1), 16384, 4096, 1024}; pg8::SchedStd S{16, 1024, G, bid}; pg8::Epi<3> E{ep}; pg8::gemm_phase<pg8::Epi<3>, pg8::SchedStd, GEMM_ALIGN, GEMM_SP2>(glds, g, S, E); }
#endif
    GRID_SYNC();
#ifndef NO_P11
    { pg8::Gemm g{(const bf16_t*)(ws + WS_ACT), (const bf16_t*)(ws + WS_WM2), 16384, 1024, 4096}; pg8::SchedStd S{4, 256, G, bid}; pg8::Epi<4> E{ep}; pg8::gemm_phase<pg8::Epi<4>, pg8::SchedStd, GEMM_ALIGN, GEMM_SP2>(glds, g, S, E); }
#endif
}
}

extern "C" void kernel_launch(void* const* d_in, const int* in_sizes, int n_in, void* d_out, int out_size, void* d_ws, size_t ws_size, hipStream_t stream) {
    static int grid = 0;
    if (grid == 0) {
        if (n_in != 21 || ws_size < mk::WS_END) { fprintf(stderr, "kernel_launch: unexpected inputs (n_in %d, ws %zu)\n", n_in, ws_size); grid = -1; return; }
        int dev = 0, cus = 0, per_cu = 0;
        hipGetDevice(&dev); hipDeviceGetAttribute(&cus, hipDeviceAttributeMultiprocessorCount, dev);
        if (hipFuncSetAttribute((const void*)mk::fwd, hipFuncAttributeMaxDynamicSharedMemorySize, mk::LDS_BYTES) != hipSuccess) { fprintf(stderr, "kernel_launch: hipFuncSetAttribute failed\n"); grid = -1; return; }
        if (hipOccupancyMaxActiveBlocksPerMultiprocessor(&per_cu, (const void*)mk::fwd, mk::NT, mk::LDS_BYTES) != hipSuccess || per_cu < 1) { fprintf(stderr, "kernel_launch: occupancy query says %d\n", per_cu); per_cu = 1; }
        (void)hipGetLastError();
        grid = cus * 1;
        if (grid % 8 != 0 || grid < 64) { fprintf(stderr, "kernel_launch: unexpected CU count %d\n", cus); }
    }
    if (grid < 0) return;
    hipMemsetAsync((char*)d_ws + mk::WS_CTL, 0, 512 * 1024, stream);
    mk::Params p{};
    for (int i = 0; i < 21; ++i) p.in[i] = (const float*)d_in[i];
    p.out = (float*)d_out; p.ws = (unsigned char*)d_ws;
    void* args[] = {&p};
    hipError_t e = hipLaunchCooperativeKernel((const void*)mk::fwd, dim3(grid), dim3(mk::NT), args, mk::LDS_BYTES, stream);
    if (e != hipSuccess) fprintf(stderr, "cooperative launch failed: %s (grid %d)\n", hipGetErrorString(e), grid);
}
```
